# Optimizing an MI355X kernel written in HIP

```python
import math
import jax, jax.numpy as jnp
from jax import lax
import numpy as np

D_MODEL = 2048
BATCH = 2
SEQ = 8192
DEPTH = 1

MIX_WIDTH = D_MODEL
CONV_WIDTH = MIX_WIDTH // 2
CONV_GROUPS = 8
MLA_HEADS = 8
QK_NOPE_DIM = 128
QK_ROPE_DIM = 64
V_HEAD_DIM = 128
Q_LORA_RANK = 768
KV_LORA_RANK = 512
ROPE_THETA = 10000.0
Q_BLOCK = 128
D_FF = 5632
CONV_K = 3
RMS_EPS = 1e-6
N_MOD = 6

IN_SPLITS = (Q_LORA_RANK, KV_LORA_RANK, QK_ROPE_DIM, CONV_WIDTH, CONV_WIDTH, CONV_WIDTH)
IN_COLS = sum(IN_SPLITS)

kernel_name = "hybrid_mla_shortconv_convffn_adaln"


def rms_norm(x, g):
    xf = x.astype(jnp.float32)
    y = xf * lax.rsqrt(jnp.mean(xf * xf, axis=-1, keepdims=True) + RMS_EPS)
    return (y * g.astype(jnp.float32)).astype(x.dtype)


def rope(x, cos, sin):
    x1, x2 = jnp.split(x, 2, axis=-1)
    return jnp.concatenate([x1 * cos - x2 * sin, x2 * cos + x1 * sin], axis=-1)


def causal_dwconv3(u, w, b):
    s = u.shape[1]
    up = jnp.pad(u, ((0, 0), (CONV_K - 1, 0), (0, 0)))
    return up[:, :s] * w[0] + up[:, 1:s + 1] * w[1] + u * w[2] + b


def mla_attention(q_nope, q_rope, k_nope, k_rope, v):
    b, s, h, _ = q_nope.shape
    nb = s // Q_BLOCK
    scale = 1.0 / math.sqrt(QK_NOPE_DIM + QK_ROPE_DIM)
    k_idx = jnp.arange(s)
    neg = jnp.finfo(jnp.float32).min

    def blockify(t):
        return t.reshape(b, nb, Q_BLOCK, *t.shape[2:]).swapaxes(0, 1)

    def one_block(args):
        qn, qr, i = args
        sc = (jnp.einsum('bqhd,bkhd->bhqk', qn, k_nope)
              + jnp.einsum('bqhd,bkd->bhqk', qr, k_rope)).astype(jnp.float32) * scale
        q_idx = i * Q_BLOCK + jnp.arange(Q_BLOCK)
        mask = k_idx[None, :] <= q_idx[:, None]
        sc = jnp.where(mask, sc, neg)
        p = jax.nn.softmax(sc, axis=-1).astype(v.dtype)
        return jnp.einsum('bhqk,bkhd->bqhd', p, v)

    out = lax.map(one_block, (blockify(q_nope), blockify(q_rope), jnp.arange(nb)))
    return out.swapaxes(0, 1).reshape(b, s, h * V_HEAD_DIM)


def setup_inputs(seed: int = 0) -> dict:
    key = jax.random.key(seed)
    ks = jax.random.split(key, 24)
    f32 = jnp.float32

    def nrm(k, shape, fan_in):
        return jax.random.normal(k, shape, f32) * (fan_in ** -0.5)

    def gain(k, n):
        return 1.0 + 0.02 * jax.random.normal(k, (DEPTH, n), f32)

    x = jax.random.normal(ks[0], (BATCH, SEQ, D_MODEL), f32)
    c = jax.random.normal(ks[1], (BATCH, D_MODEL), f32)
    offset = jax.random.randint(ks[2], (BATCH, 1), 0, 1024, dtype=jnp.int32)
    positions = offset + jnp.arange(SEQ, dtype=jnp.int32)[None, :]
    return {
        "x": x,
        "c": c,
        "positions": positions,
        "w_ada": nrm(ks[3], (DEPTH, D_MODEL, N_MOD * D_MODEL), D_MODEL),
        "b_ada": 0.02 * jax.random.normal(ks[4], (DEPTH, N_MOD * D_MODEL), f32),
        "g_pre_mix": gain(ks[5], D_MODEL),
        "g_post_mix": gain(ks[6], D_MODEL),
        "w_in": nrm(ks[7], (DEPTH, D_MODEL, IN_COLS), D_MODEL),
        "g_q": gain(ks[8], Q_LORA_RANK),
        "w_uq": nrm(ks[9], (DEPTH, Q_LORA_RANK, MLA_HEADS * (QK_NOPE_DIM + QK_ROPE_DIM)), Q_LORA_RANK),
        "g_kv": gain(ks[10], KV_LORA_RANK),
        "w_ukv": nrm(ks[11], (DEPTH, KV_LORA_RANK, MLA_HEADS * (QK_NOPE_DIM + V_HEAD_DIM)), KV_LORA_RANK),
        "conv_w_mix": nrm(ks[12], (DEPTH, CONV_K, CONV_WIDTH), CONV_K),
        "conv_b_mix": 0.02 * jax.random.normal(ks[13], (DEPTH, CONV_WIDTH), f32),
        "w_o": nrm(ks[14], (DEPTH, MIX_WIDTH, D_MODEL), MIX_WIDTH),
        "g_pre_ffn": gain(ks[15], D_MODEL),
        "g_post_ffn": gain(ks[16], D_MODEL),
        "w_up": nrm(ks[17], (DEPTH, D_MODEL, 2 * D_FF), D_MODEL),
        "conv_w_ffn": nrm(ks[18], (DEPTH, CONV_K, 2 * D_FF), CONV_K),
        "conv_b_ffn": 0.02 * jax.random.normal(ks[19], (DEPTH, 2 * D_FF), f32),
        "w_down": nrm(ks[20], (DEPTH, D_FF, D_MODEL), D_FF),
    }


def reference(x, c, positions, w_ada, b_ada, g_pre_mix, g_post_mix, w_in, g_q, w_uq,
              g_kv, w_ukv, conv_w_mix, conv_b_mix, w_o, g_pre_ffn, g_post_ffn,
              w_up, conv_w_ffn, conv_b_ffn, w_down):
    b, s, _ = x.shape
    inv_freq = 1.0 / (ROPE_THETA ** (jnp.arange(0, QK_ROPE_DIM, 2, dtype=jnp.float32) / QK_ROPE_DIM))
    ang = positions.astype(jnp.float32)[..., None] * inv_freq
    cos = jnp.cos(ang).astype(x.dtype)
    sin = jnp.sin(ang).astype(x.dtype)
    c_act = jax.nn.silu(c)
    cut = np.cumsum(IN_SPLITS)[:-1].tolist()

    for l in range(DEPTH):
        mod = c_act @ w_ada[l] + b_ada[l]
        sh_m, sc_m, gt_m, sh_f, sc_f, gt_f = [m[:, None, :] for m in jnp.split(mod, N_MOD, axis=-1)]

        h = rms_norm(x, g_pre_mix[l]) * (1.0 + sc_m) + sh_m
        proj = h @ w_in[l]
        q_lat, kv_lat, k_rope, gate_b, gate_c, conv_in = jnp.split(proj, cut, axis=-1)

        q = (rms_norm(q_lat, g_q[l]) @ w_uq[l]).reshape(b, s, MLA_HEADS, QK_NOPE_DIM + QK_ROPE_DIM)
        q_nope, q_rope = q[..., :QK_NOPE_DIM], q[..., QK_NOPE_DIM:]
        q_rope = rope(q_rope, cos[:, :, None, :], sin[:, :, None, :])
        k_rope = rope(k_rope, cos, sin)
        kv = (rms_norm(kv_lat, g_kv[l]) @ w_ukv[l]).reshape(b, s, MLA_HEADS, QK_NOPE_DIM + V_HEAD_DIM)
        k_nope, v = kv[..., :QK_NOPE_DIM], kv[..., QK_NOPE_DIM:]
        attn_out = mla_attention(q_nope, q_rope, k_nope, k_rope, v)

        conv_out = gate_b * causal_dwconv3(gate_c * conv_in, conv_w_mix[l], conv_b_mix[l])

        mix = jnp.concatenate([attn_out, conv_out], axis=-1) @ w_o[l]
        x = x + gt_m * rms_norm(mix, g_post_mix[l])

        h = rms_norm(x, g_pre_ffn[l]) * (1.0 + sc_f) + sh_f
        u = causal_dwconv3(h @ w_up[l], conv_w_ffn[l], conv_b_ffn[l])
        a, g = jnp.split(u, 2, axis=-1)
        y = (jax.nn.silu(g) * a) @ w_down[l]
        x = x + gt_f * rms_norm(y, g_post_ffn[l])
    return x
```

```cpp
#include <hip/hip_runtime.h>
#include <hip/hip_cooperative_groups.h>
#include <cstdio>
#include <cstdint>
namespace cg = cooperative_groups;

constexpr int BATCH = 2, SEQ = 8192, DM = 2048, M = BATCH * SEQ;
constexpr int QL = 768, KVL = 512, ROPE = 64, CW = 1024, INC = 4416, INP = 4608;
constexpr int NH = 8, DQK = 192, NQ = NH * DQK  , NKV = NH * 256  ;
constexpr int DFF = 5632, NUP = 2 * DFF;
constexpr int NMODC = 6 * DM;
constexpr float RMS_EPS = 1e-6f;
constexpr int PC_Q = 0, PC_KV = 768, PC_GB = 1280, PC_GC = 2304, PC_CI = 3328, PC_KR = 4352;
constexpr int UP_TA = 20, UP_TB = 24;

constexpr size_t MiB = 1u << 20;
constexpr size_t WS_WUP = 0, WS_WDN = 44 * MiB, WS_MOD = 66 * MiB;
constexpr size_t WS_XN = 68 * MiB;
constexpr size_t WS_WIN = 132 * MiB, WS_WUQ = 150 * MiB, WS_WUKV = 153 * MiB, WS_WO = 155 * MiB, WS_CS = 163 * MiB;
constexpr size_t WS_PROJ = 168 * MiB;
constexpr size_t WS_QN = 312 * MiB, WS_KVN = 336 * MiB, WS_KR = 352 * MiB, WS_Q = 354 * MiB, WS_KV = 402 * MiB;
constexpr size_t WS_U = 132 * MiB;
constexpr size_t WS_ACT = 324 * MiB;
constexpr size_t WS_Y = 132 * MiB;
constexpr size_t WS_END = 500 * MiB;

#define LAS __attribute__((address_space(3)))
typedef unsigned u32x4 __attribute__((ext_vector_type(4)));
typedef unsigned u32x2 __attribute__((ext_vector_type(2)));
typedef float f32x2 __attribute__((ext_vector_type(2)));
typedef unsigned short bf16_t;
typedef short bf16x8 __attribute__((ext_vector_type(8)));
typedef short s16x4 __attribute__((ext_vector_type(4)));
typedef float f32x4 __attribute__((ext_vector_type(4)));
typedef float f32x16 __attribute__((ext_vector_type(16)));
namespace pg8 {
#define PG8_LAS __attribute__((address_space(3)))
typedef unsigned short bf16_t;
typedef short bf16x8 __attribute__((ext_vector_type(8)));
typedef float f32x4 __attribute__((ext_vector_type(4)));
typedef unsigned u32x4 __attribute__((ext_vector_type(4)));
constexpr int BM = 256, BK = 64, HALF = 128, HTB = HALF * BK * 2  , STAGE_BYTES = 8 * HTB, NXCD = 8, WGM = 8;

__host__ __device__ __forceinline__ int lds_byte(int r, int c) { const int st = (r >> 4) * 2 + (c >> 5), rr = r & 15, cc = c & 31, ob = rr * 64 + cc * 2; return st * 1024 + (ob ^ (((ob >> 9) & 1) << 5)); }
__host__ __device__ __forceinline__ void stage_rc(int b, int& R, int& C) { const int st = b / 1024, sb = b % 1024, swz = sb ^ (((sb >> 9) & 1) << 5); R = (st >> 1) * 16 + swz / 64; C = (st & 1) * 32 + (swz % 64) / 2; }
__host__ __device__ __forceinline__ int perm32(int rho) { const int n = rho >> 4, i = rho & 15; return 8 * (i >> 2) + 4 * n + (i & 3); }

struct Unit { int pm, pn; };
struct Gemm { const bf16_t* A; const bf16_t* Bt; int M, N, K; };

struct StaticOrder {
    int nM, nN, nwg, G, c;
    __host__ __device__ void init(int M, int N, int G_, int c_) { nM = M / BM; nN = N / BM; nwg = nM * nN; G = G_; c = c_; }
    __host__ __device__ bool next(int i, Unit& u) const {
        const long L = (long)i * G + c; if (L >= nwg) return false;
        int wgid = (int)L; { const int q = nwg / NXCD, r = nwg % NXCD, xcd = wgid % NXCD, off = wgid / NXCD; wgid = (xcd < r ? xcd * (q + 1) : r * (q + 1) + (xcd - r) * q) + off; }
        const int nig = WGM * nN, gid = wgid / nig, fm = gid * WGM, gsz = (nM - fm) < WGM ? (nM - fm) : WGM;
        u.pm = fm + ((wgid % nig) % gsz); u.pn = (wgid % nig) / gsz; return true;
    }
    __device__ __forceinline__ void a_ready(const Unit&) const {}
    __device__ __forceinline__ void done(const Unit&) const {}
};

__device__ __forceinline__ unsigned cvt_pk_bf16(float lo, float hi) { unsigned r; asm volatile("v_cvt_pk_bf16_f32 %0, %1, %2" : "=v"(r) : "v"(lo), "v"(hi)); return r; }
struct EpiBf16 {
    static constexpr bool PERM = true, AFTER_DRAIN = false;
    bf16_t* O; int ldc;
    __device__ __forceinline__ void operator()(const f32x4 (&acc)[2][2][4][2], const Unit& u, int wr, int wc, int fr, int fq) const {
        const int row0 = u.pm * BM + wr * 64 + fr, col0 = u.pn * BM + wc * 32 + 8 * fq;
#pragma unroll
        for (int ai = 0; ai < 2; ++ai)
#pragma unroll
            for (int m = 0; m < 4; ++m) { bf16_t* rowp = O + (size_t)(row0 + ai * HALF + m * 16) * ldc + col0;
#pragma unroll
                for (int bj = 0; bj < 2; ++bj) { const f32x4 v0 = acc[ai][bj][m][0], v1 = acc[ai][bj][m][1];
                    u32x4 w; w.x = cvt_pk_bf16(v0[0], v0[1]); w.y = cvt_pk_bf16(v0[2], v0[3]); w.z = cvt_pk_bf16(v1[0], v1[1]); w.w = cvt_pk_bf16(v1[2], v1[3]);
                    *(u32x4*)(rowp + bj * HALF) = w; } }
    }
};
struct EpiF32 {
    static constexpr bool PERM = true, AFTER_DRAIN = false;
    float* O; int ldc;
    __device__ __forceinline__ void operator()(const f32x4 (&acc)[2][2][4][2], const Unit& u, int wr, int wc, int fr, int fq) const {
        const int row0 = u.pm * BM + wr * 64 + fr, col0 = u.pn * BM + wc * 32 + 8 * fq;
#pragma unroll
        for (int ai = 0; ai < 2; ++ai)
#pragma unroll
            for (int m = 0; m < 4; ++m) { float* rowp = O + (size_t)(row0 + ai * HALF + m * 16) * ldc + col0;
#pragma unroll
                for (int bj = 0; bj < 2; ++bj) { *(f32x4*)(rowp + bj * HALF) = acc[ai][bj][m][0]; *(f32x4*)(rowp + bj * HALF + 4) = acc[ai][bj][m][1]; } }
    }
};
struct EpiQ {
    static constexpr bool PERM = true, AFTER_DRAIN = false;
    bf16_t* O; const float* CS;
    __device__ __forceinline__ void operator()(const f32x4 (&acc)[2][2][4][2], const Unit& u, int wr, int wc, int fr, int fq) const {
        const int row0 = u.pm * BM + wr * 64 + fr;
#pragma unroll
        for (int bj = 0; bj < 2; ++bj) {
            const int cb = u.pn * BM + bj * HALF + wc * 32, within = cb % 192; const bool rope = within >= 128;
            const int j0 = ((within - 128) >> 1) + 4 * fq;
#pragma unroll
            for (int ai = 0; ai < 2; ++ai)
#pragma unroll
                for (int m = 0; m < 4; ++m) { const int row = row0 + ai * HALF + m * 16;
                    f32x4 v0 = acc[ai][bj][m][0], v1 = acc[ai][bj][m][1];
                    if (rope) { const f32x4 c0 = *(const f32x4*)(CS + (size_t)row * 64 + j0 * 2), c1 = *(const f32x4*)(CS + (size_t)row * 64 + j0 * 2 + 4);
                        f32x4 a, b;
                        a[0] = v0[0] * c0[0] - v0[1] * c0[1]; a[1] = v0[1] * c0[0] + v0[0] * c0[1]; a[2] = v0[2] * c0[2] - v0[3] * c0[3]; a[3] = v0[3] * c0[2] + v0[2] * c0[3];
                        b[0] = v1[0] * c1[0] - v1[1] * c1[1]; b[1] = v1[1] * c1[0] + v1[0] * c1[1]; b[2] = v1[2] * c1[2] - v1[3] * c1[3]; b[3] = v1[3] * c1[2] + v1[2] * c1[3];
                        v0 = a; v1 = b; }
                    u32x4 w; w.x = cvt_pk_bf16(v0[0], v0[1]); w.y = cvt_pk_bf16(v0[2], v0[3]); w.z = cvt_pk_bf16(v1[0], v1[1]); w.w = cvt_pk_bf16(v1[2], v1[3]);
                    *(u32x4*)(O + (size_t)row * NQ + cb + 8 * fq) = w; }
        }
    }
};
template <class Epi, class Sched, bool ALIGN_EPI = false, bool SP2 = false>
__device__ __forceinline__ void gemm_phase(PG8_LAS unsigned char* lds, const Gemm g, const Sched& S, const Epi& E) {
    int tid_o = threadIdx.x; asm volatile("" : "+v"(tid_o)); const int tid = tid_o, wid = __builtin_amdgcn_readfirstlane(tid >> 6), lane = tid & 63, wr = wid >> 2, wc = wid & 3, fr = lane & 15, fq = lane >> 4;
    const int K = g.K, nt = K / BK;
    unsigned voffA[2], voffB[2];
#pragma unroll
    for (int i = 0; i < 2; ++i) { int R, C; stage_rc(tid * 16 + i * 8192, R, C); const int Rb = Epi::PERM ? ((R & ~31) + perm32(R & 31)) : R;
        voffA[i] = (unsigned)(R * K + C) * 2u; voffB[i] = (unsigned)(Rb * K + C) * 2u; }
    const size_t kstep = (size_t)(BK * 2);
    const size_t hstep = (size_t)HALF * K * 2;
    const size_t tstep = 2 * hstep;
    const unsigned ldsw = (unsigned)wid * 1024u;
    const int aoff = lds_byte(wr * 64 + fr, fq * 8), boff = lds_byte(wc * 32 + fr, fq * 8);
#define PG8_SA(b, h) (((b) * 2 + (h)) * HTB)
#define PG8_SB(b, h) ((4 + (b) * 2 + (h)) * HTB)
#define PG8_STAGE(bufoff, gbase, voff) do { _Pragma("unroll") for (int _i = 0; _i < 2; ++_i) \
        __builtin_amdgcn_global_load_lds((const unsigned*)((const char*)(gbase) + (voff)[_i]), (PG8_LAS unsigned*)(lds + (bufoff) + ldsw + _i * 8192), 16, 0, 0); } while (0)
#define PG8_LDA(dst, b, h) do { _Pragma("unroll") for (int m = 0; m < 4; ++m) _Pragma("unroll") for (int k = 0; k < 2; ++k) dst[m][k] = *(const PG8_LAS bf16x8*)(lds + PG8_SA(b, h) + aoff + m * 2048 + k * 1024); } while (0)
#define PG8_LDB(dst, b, h) do { _Pragma("unroll") for (int n = 0; n < 2; ++n) _Pragma("unroll") for (int k = 0; k < 2; ++k) dst[n][k] = *(const PG8_LAS bf16x8*)(lds + PG8_SB(b, h) + boff + n * 2048 + k * 1024); } while (0)
#define PG8_MMA(ai, bj, At, Bt) do { __builtin_amdgcn_s_setprio(1); _Pragma("unroll") for (int m = 0; m < 4; ++m) _Pragma("unroll") for (int n = 0; n < 2; ++n) _Pragma("unroll") for (int k = 0; k < 2; ++k) \
        acc[ai][bj][m][n] = __builtin_amdgcn_mfma_f32_16x16x32_bf16(Bt[n][k], At[m][k], acc[ai][bj][m][n], 0, 0, 0); __builtin_amdgcn_s_setprio(0); } while (0)
#define PG8_WAIT_V(n) asm volatile("s_waitcnt vmcnt(" #n ")" ::: "memory")
#define PG8_WAIT_L(n) asm volatile("s_waitcnt lgkmcnt(" #n ")" ::: "memory")
#define PG8_BAR __builtin_amdgcn_s_barrier()
#define PG8_SCHED __builtin_amdgcn_sched_barrier(0)
    Unit cur, nxt; int ui = 0;
    if (!S.next(0, cur)) return;
    f32x4 acc[2][2][4][2];
#pragma unroll
    for (int a = 0; a < 2; ++a)
#pragma unroll
        for (int b = 0; b < 2; ++b)
#pragma unroll
            for (int m = 0; m < 4; ++m)
#pragma unroll
                for (int n = 0; n < 2; ++n) acc[a][b][m][n] = (f32x4){0.f, 0.f, 0.f, 0.f};
    bf16x8 At[4][2], B0[2][2], B1[2][2];
    const char* cA = (const char*)g.A + (size_t)cur.pm * tstep; const char* cB = (const char*)g.Bt + (size_t)cur.pn * tstep;
    S.a_ready(cur);
    if constexpr (SP2) {
        PG8_STAGE(PG8_SB(0, 0), cB, voffB); PG8_STAGE(PG8_SB(0, 1), cB + hstep, voffB); PG8_STAGE(PG8_SA(0, 0), cA, voffA); PG8_STAGE(PG8_SA(0, 1), cA + hstep, voffA);
        if (wr == 1) PG8_BAR;
        PG8_WAIT_V(2); PG8_BAR;
        PG8_STAGE(PG8_SB(1, 0), cB + kstep, voffB); PG8_STAGE(PG8_SA(1, 0), cA + kstep, voffA); PG8_STAGE(PG8_SB(1, 1), cB + hstep + kstep, voffB);
        PG8_WAIT_V(6); PG8_BAR;
    } else {
        PG8_STAGE(PG8_SB(0, 0), cB, voffB); PG8_STAGE(PG8_SA(0, 0), cA, voffA); PG8_STAGE(PG8_SB(0, 1), cB + hstep, voffB); PG8_STAGE(PG8_SA(0, 1), cA + hstep, voffA);
        if (wr == 1) PG8_BAR;
        PG8_WAIT_V(4); PG8_BAR;
        PG8_STAGE(PG8_SB(1, 0), cB + kstep, voffB); PG8_STAGE(PG8_SA(1, 0), cA + kstep, voffA); PG8_STAGE(PG8_SB(1, 1), cB + hstep + kstep, voffB);
        PG8_WAIT_V(6); PG8_BAR;
    }
    for (;;) {
        const bool has_next = S.next(ui + 1, nxt);
        const char* nA = has_next ? (const char*)g.A + (size_t)nxt.pm * tstep : cA; const char* nB = has_next ? (const char*)g.Bt + (size_t)nxt.pn * tstep : cB;
        for (int t = 0; t < nt; t += 2) {
            const bool last = (t == nt - 2);
            const char* a1 = cA + (size_t)(t + 1) * kstep;
            const char* a2 = last ? nA : cA + (size_t)(t + 2) * kstep; const char* b2 = last ? nB : cB + (size_t)(t + 2) * kstep;
            const char* a3 = a2 + kstep; const char* b3 = b2 + kstep;
            if (last && has_next) S.a_ready(nxt);
            if constexpr (SP2) {
            PG8_LDB(B0, 0, 0); PG8_LDB(B1, 0, 1); PG8_SCHED; PG8_LDA(At, 0, 0); PG8_STAGE(PG8_SA(1, 1), a1 + hstep, voffA);
            PG8_WAIT_V(8); PG8_WAIT_L(0); PG8_BAR; PG8_MMA(0, 0, At, B0); PG8_MMA(0, 1, At, B1); PG8_BAR; PG8_SCHED;
            PG8_LDA(At, 0, 1); PG8_STAGE(PG8_SB(0, 0), b2, voffB); PG8_STAGE(PG8_SB(0, 1), b2 + hstep, voffB); PG8_STAGE(PG8_SA(0, 0), a2, voffA);
            PG8_WAIT_V(8); PG8_WAIT_L(0); PG8_BAR; PG8_MMA(1, 0, At, B0); PG8_MMA(1, 1, At, B1); PG8_BAR; PG8_SCHED;
            PG8_LDB(B0, 1, 0); PG8_LDB(B1, 1, 1); PG8_SCHED; PG8_LDA(At, 1, 0); PG8_STAGE(PG8_SA(0, 1), a2 + hstep, voffA);
            PG8_WAIT_V(8); PG8_WAIT_L(0); PG8_BAR; PG8_MMA(0, 0, At, B0); PG8_MMA(0, 1, At, B1); PG8_BAR; PG8_SCHED;
            PG8_LDA(At, 1, 1); PG8_STAGE(PG8_SB(1, 0), b3, voffB); PG8_STAGE(PG8_SB(1, 1), b3 + hstep, voffB); PG8_STAGE(PG8_SA(1, 0), a3, voffA);
            PG8_WAIT_V(8); PG8_WAIT_L(0); PG8_BAR; PG8_MMA(1, 0, At, B0); PG8_MMA(1, 1, At, B1); PG8_BAR; PG8_SCHED;
            } else {
            PG8_LDB(B0, 0, 0); PG8_SCHED; PG8_LDA(At, 0, 0); PG8_STAGE(PG8_SA(1, 1), a1 + hstep, voffA);
            PG8_WAIT_L(8); PG8_BAR; PG8_WAIT_L(0); PG8_MMA(0, 0, At, B0); PG8_BAR; PG8_SCHED;
            PG8_LDB(B1, 0, 1); PG8_STAGE(PG8_SB(0, 0), b2, voffB);
            PG8_BAR; PG8_WAIT_L(0); PG8_MMA(0, 1, At, B1); PG8_BAR;
            PG8_LDA(At, 0, 1); PG8_STAGE(PG8_SA(0, 0), a2, voffA);
            PG8_BAR; PG8_WAIT_L(0); PG8_MMA(1, 0, At, B0); PG8_BAR; PG8_SCHED;
            PG8_STAGE(PG8_SB(0, 1), b2 + hstep, voffB);
            PG8_WAIT_V(6); PG8_BAR; PG8_MMA(1, 1, At, B1); PG8_BAR;
            PG8_LDB(B0, 1, 0); PG8_SCHED; PG8_LDA(At, 1, 0); PG8_STAGE(PG8_SA(0, 1), a2 + hstep, voffA);
            PG8_WAIT_L(8); PG8_BAR; PG8_WAIT_L(0); PG8_MMA(0, 0, At, B0); PG8_BAR; PG8_SCHED;
            PG8_LDB(B1, 1, 1); PG8_STAGE(PG8_SB(1, 0), b3, voffB);
            PG8_BAR; PG8_WAIT_L(0); PG8_MMA(0, 1, At, B1); PG8_BAR;
            PG8_LDA(At, 1, 1); PG8_STAGE(PG8_SA(1, 0), a3, voffA);
            PG8_BAR; PG8_WAIT_L(0); PG8_MMA(1, 0, At, B0); PG8_BAR; PG8_SCHED;
            PG8_STAGE(PG8_SB(1, 1), b3 + hstep, voffB);
            PG8_WAIT_V(6); PG8_BAR; PG8_MMA(1, 1, At, B1); PG8_BAR;
            }
        }
        if constexpr (ALIGN_EPI) { if (wr == 0) PG8_BAR; }
        if constexpr (!Epi::AFTER_DRAIN) { E(acc, cur, wr, wc, fr, fq); S.done(cur); }
        if (!has_next) break;
#pragma unroll
        for (int a = 0; a < 2; ++a)
#pragma unroll
            for (int b = 0; b < 2; ++b)
#pragma unroll
                for (int m = 0; m < 4; ++m)
#pragma unroll
                    for (int n = 0; n < 2; ++n) acc[a][b][m][n] = (f32x4){0.f, 0.f, 0.f, 0.f};
        cur = nxt; cA = nA; cB = nB; ++ui;
        if constexpr (ALIGN_EPI) { if (wr == 1) PG8_BAR; }
    }
    PG8_WAIT_V(0);
    if constexpr (!ALIGN_EPI) { if (wr == 0) PG8_BAR; }
    PG8_BAR;
    if constexpr (Epi::AFTER_DRAIN) { E.fused(acc, cur, wr, wc, fr, fq, lds, wid, lane); S.done(cur); }
#undef PG8_SA
#undef PG8_SB
#undef PG8_STAGE
#undef PG8_LDA
#undef PG8_LDB
#undef PG8_MMA
#undef PG8_WAIT_V
#undef PG8_WAIT_L
#undef PG8_BAR
#undef PG8_SCHED
}
}
namespace att {
constexpr int NW = 8, QBLK = 32, KVBLK = 64, QB = NW * QBLK, DV = 128;
constexpr int KROW = 400;
constexpr int SHM_K = KVBLK * KROW, SHM_V = KVBLK * DV * 2;
constexpr int OFF_V = 0, OFF_K = 2 * SHM_V, OFF_WS = OFF_K + 2 * SHM_K, LDS_BYTES = OFF_WS + NW * 64 * 4;
constexpr float SCALE = 0.07216878364870322f;
constexpr float THR = 8.f;
#define SBAR() __builtin_amdgcn_sched_barrier(0)
__device__ __forceinline__ int v_st(int k, int c) { const int kk = (k & ~0xC) | ((k & 4) << 1) | ((k & 8) >> 1); return ((kk >> 3) * 4 + (c >> 5)) * 512 + ((kk & 7) * 32 + (c & 31)) * 2; }
__device__ __forceinline__ int v_rd_base(int lane) { return ((lane & 3) << 3) | (((lane >> 2) & 3) << 6) | (((lane >> 4) & 1) << 5) | (((lane >> 5) & 1) << 8); }
constexpr int v_rd_off(int d0, int ks, int half) { return d0 * 512 + ks * 4096 + half * 2048; }
__device__ __forceinline__ int crow(int r, int hi) { return (r & 3) + 8 * (r >> 2) + 4 * hi; }
__device__ __forceinline__ unsigned cvtpk(float lo, float hi) { unsigned r; asm volatile("v_cvt_pk_bf16_f32 %0, %1, %2" : "=v"(r) : "v"(lo), "v"(hi)); return r; }
__device__ __forceinline__ void mask_tile(f32x16& p0, f32x16& p1, int dq) {
    const float NEG = -__builtin_inff();
#pragma unroll
    for (int r = 0; r < 16; ++r) { const int c = (r & 3) + 8 * (r >> 2);
        if (dq - c < 0) p0[r] = NEG;
        if (dq - c - 32 < 0) p1[r] = NEG; }
}
__device__ __forceinline__ void partialSM(f32x16& p0, f32x16& p1, float& m_reg, float& mn, float& alpha) {
    float pmax = p0[0];
#pragma unroll
    for (int r = 1; r < 16; ++r) pmax = fmaxf(pmax, p0[r]);
#pragma unroll
    for (int r = 0; r < 16; ++r) pmax = fmaxf(pmax, p1[r]);
    { auto rr = __builtin_amdgcn_permlane32_swap(__float_as_uint(pmax), __float_as_uint(pmax), false, false);
      pmax = fmaxf(__uint_as_float(rr[0]), __uint_as_float(rr[1])); }
    constexpr float C2 = 1.4426950408889634f * SCALE;
    if (__builtin_expect(__all((pmax - m_reg) * SCALE <= THR), 1)) { mn = m_reg; alpha = 1.f; }
    else { mn = fmaxf(m_reg, pmax); alpha = __builtin_amdgcn_exp2f((m_reg - mn) * C2); m_reg = mn; }
    const float mnL = -mn * C2;
#pragma unroll
    for (int r = 0; r < 16; ++r) p0[r] = fmaf(p0[r], C2, mnL);
#pragma unroll
    for (int r = 0; r < 16; ++r) p1[r] = fmaf(p1[r], C2, mnL);
#pragma unroll
    for (int r = 0; r < 16; ++r) p0[r] = __builtin_amdgcn_exp2f(p0[r]);
}
__device__ __forceinline__ void finishSM(f32x16& p0, f32x16& p1, float alpha, float& l_reg, bf16x8& pa0, bf16x8& pa1, bf16x8& pa2, bf16x8& pa3) {
#pragma unroll
    for (int r = 0; r < 16; ++r) p1[r] = __builtin_amdgcn_exp2f(p1[r]);
    float ps = 0;
#pragma unroll
    for (int r = 0; r < 16; ++r) ps += p0[r];
#pragma unroll
    for (int r = 0; r < 16; ++r) ps += p1[r];
    { auto rr = __builtin_amdgcn_permlane32_swap(__float_as_uint(ps), __float_as_uint(ps), false, false);
      ps = __uint_as_float(rr[0]) + __uint_as_float(rr[1]); }
    l_reg = l_reg * alpha + ps;
#define PK4(P, B_, OUT) do { unsigned a0 = cvtpk(P[B_+0], P[B_+1]), a1 = cvtpk(P[B_+2], P[B_+3]);                          \
        unsigned b0 = cvtpk(P[B_+4], P[B_+5]), b1 = cvtpk(P[B_+6], P[B_+7]);                                             \
        auto r0 = __builtin_amdgcn_permlane32_swap(a0, b0, false, false); auto r1 = __builtin_amdgcn_permlane32_swap(a1, b1, false, false); \
        u32x4 w = {r0[0], r1[0], r0[1], r1[1]}; OUT = *reinterpret_cast<bf16x8*>(&w); } while (0)
    PK4(p0, 0, pa0); PK4(p0, 8, pa1); PK4(p1, 0, pa2); PK4(p1, 8, pa3);
#undef PK4
}
__device__ __forceinline__ void qkt(f32x16& p0, f32x16& p1, const char* Kb, int r32, int hi, const bf16x8* qr) {
    p0 = f32x16{}; p1 = f32x16{};
    const char* a = Kb + r32 * KROW + hi * 16;
#pragma unroll
    for (int d0 = 0; d0 < 12; ++d0) {
        const bf16x8 b0 = *reinterpret_cast<const bf16x8*>(a + d0 * 32);
        const bf16x8 b1 = *reinterpret_cast<const bf16x8*>(a + d0 * 32 + 32 * KROW);
        p0 = __builtin_amdgcn_mfma_f32_32x32x16_bf16(b0, qr[d0], p0, 0, 0, 0);
        p1 = __builtin_amdgcn_mfma_f32_32x32x16_bf16(b1, qr[d0], p1, 0, 0, 0); }
}
__device__ __forceinline__ void pv_tile(f32x16* o, int vb0, bf16x8 pa0, bf16x8 pa1, bf16x8 pa2, bf16x8 pa3) {
#define TRRD(dst, off) asm volatile("ds_read_b64_tr_b16 %0, %1 offset:%2" : "=&v"(dst) : "v"(vb0), "i"(off) : "memory")
#define PV_D0(d0) do { s16x4 l0, l1, l2, l3, h0, h1, h2, h3; constexpr int b_ = v_rd_off(d0, 0, 0); \
        TRRD(l0, b_); TRRD(h0, b_ + 2048); TRRD(l1, b_ + 4096); TRRD(h1, b_ + 6144); TRRD(l2, b_ + 8192); TRRD(h2, b_ + 10240); TRRD(l3, b_ + 12288); TRRD(h3, b_ + 14336); \
        asm volatile("s_waitcnt lgkmcnt(0)" ::: "memory"); SBAR();   \
        o[d0] = __builtin_amdgcn_mfma_f32_32x32x16_bf16(pa0, (bf16x8){l0[0], l0[1], l0[2], l0[3], h0[0], h0[1], h0[2], h0[3]}, o[d0], 0, 0, 0);   \
        o[d0] = __builtin_amdgcn_mfma_f32_32x32x16_bf16(pa1, (bf16x8){l1[0], l1[1], l1[2], l1[3], h1[0], h1[1], h1[2], h1[3]}, o[d0], 0, 0, 0);   \
        o[d0] = __builtin_amdgcn_mfma_f32_32x32x16_bf16(pa2, (bf16x8){l2[0], l2[1], l2[2], l2[3], h2[0], h2[1], h2[2], h2[3]}, o[d0], 0, 0, 0);   \
        o[d0] = __builtin_amdgcn_mfma_f32_32x32x16_bf16(pa3, (bf16x8){l3[0], l3[1], l3[2], l3[3], h3[0], h3[1], h3[2], h3[3]}, o[d0], 0, 0, 0); } while (0)
    PV_D0(0); PV_D0(1); PV_D0(2); PV_D0(3);
#undef PV_D0
#undef TRRD
}
__device__ __forceinline__ void attn_unit(int b, int h, int qb, const bf16_t* __restrict__ Q, const bf16_t* __restrict__ KVp, const bf16_t* __restrict__ KR, bf16_t* __restrict__ O, char* lds) {
    int tid_o = threadIdx.x; asm volatile("" : "+v"(tid_o)); const int tid = tid_o, wid = __builtin_amdgcn_readfirstlane(tid >> 6), lane = tid & 63, r32 = lane & 31, hi = lane >> 5;
    const size_t rowbase = (size_t)b * SEQ; const int q0 = qb * QB;
    char* V_lds = lds + OFF_V; char* K_lds = lds + OFF_K;
    float* ws = (float*)(lds + OFF_WS) + wid * 64; float* li_l = ws; float* al_l = ws + 32;
    bf16x8 qr[12];
    { const bf16_t* Qw = Q + (rowbase + q0 + wid * QBLK + r32) * NQ + h * DQK + hi * 8;
#pragma unroll
      for (int d0 = 0; d0 < 12; ++d0) qr[d0] = *reinterpret_cast<const bf16x8*>(Qw + d0 * 16); }
    const bf16_t* ksrc[3]; int kstr[3], kdst[3];
#pragma unroll
    for (int i = 0; i < 3; ++i) { const int c = tid + 512 * i, kr = c / 24, kc = c - kr * 24;
        if (kc < 16) { ksrc[i] = KVp + (rowbase + kr) * NKV + h * 256 + kc * 8; kstr[i] = KVBLK * NKV; }
        else { ksrc[i] = KR + (rowbase + kr) * 64 + (kc - 16) * 8; kstr[i] = KVBLK * 64; }
        kdst[i] = kr * KROW + kc * 16; }
    const int sr = tid >> 4, sc = (tid & 15) * 8;
    const bf16_t* vsrc = KVp + (rowbase + sr) * NKV + h * 256 + 128 + sc;
    const int vst0 = v_st(sr, sc), vst1 = v_st(32 + sr, sc);
    const int vb0 = (int)(uintptr_t)V_lds + v_rd_base(lane);
    const int NT = 4 * qb + 4;
    const int qlo = q0 + wid * QBLK, qm = qlo + r32 - 4 * hi;
    bf16x8 sk0, sk1, sk2, sv0, sv1;
#define SLOAD(t) do { sk0 = *reinterpret_cast<const bf16x8*>(ksrc[0] + (size_t)(t) * kstr[0]); sk1 = *reinterpret_cast<const bf16x8*>(ksrc[1] + (size_t)(t) * kstr[1]); \
        sk2 = *reinterpret_cast<const bf16x8*>(ksrc[2] + (size_t)(t) * kstr[2]); \
        sv0 = *reinterpret_cast<const bf16x8*>(vsrc + (size_t)(t) * KVBLK * NKV); sv1 = *reinterpret_cast<const bf16x8*>(vsrc + (size_t)(t) * KVBLK * NKV + 32 * NKV); } while (0)
#define SWRITE(bf) do { *reinterpret_cast<bf16x8*>(K_lds + (bf) * SHM_K + kdst[0]) = sk0; *reinterpret_cast<bf16x8*>(K_lds + (bf) * SHM_K + kdst[1]) = sk1; \
        *reinterpret_cast<bf16x8*>(K_lds + (bf) * SHM_K + kdst[2]) = sk2; \
        *reinterpret_cast<bf16x8*>(V_lds + (bf) * SHM_V + vst0) = sv0; *reinterpret_cast<bf16x8*>(V_lds + (bf) * SHM_V + vst1) = sv1; } while (0)
    SLOAD(0); SWRITE(0); __syncthreads();
    float m_reg = -1e30f, l_reg = 0.f; f32x16 o[4];
#pragma unroll
    for (int d = 0; d < 4; ++d) o[d] = f32x16{};
    for (int t = 0; t < NT; ++t) {
        const int cur = t & 1;
        if (t + 1 < NT) { SLOAD(t + 1); } SBAR();
        f32x16 p0, p1; float mn, alpha; bf16x8 pa0, pa1, pa2, pa3;
        qkt(p0, p1, K_lds + cur * SHM_K, r32, hi, qr);
        const int kb = t * KVBLK;
        if (kb + KVBLK - 1 > qlo) mask_tile(p0, p1, qm - kb);
        partialSM(p0, p1, m_reg, mn, alpha);
        if (__any(alpha < 1.f)) { if (hi == 0) al_l[r32] = alpha; asm volatile("s_waitcnt lgkmcnt(0)" ::: "memory");
#pragma unroll
            for (int d_ = 0; d_ < 4; ++d_)
#pragma unroll
                for (int r = 0; r < 16; ++r) o[d_][r] *= al_l[crow(r, hi)]; }
        finishSM(p0, p1, alpha, l_reg, pa0, pa1, pa2, pa3); SBAR();
        pv_tile(o, vb0 + cur * SHM_V, pa0, pa1, pa2, pa3);
        if (t + 1 < NT) { SWRITE(cur ^ 1); }
        __syncthreads();
    }
    if (hi == 0) li_l[r32] = l_reg; asm volatile("s_waitcnt lgkmcnt(0)" ::: "memory");
    float rli[16];
#pragma unroll
    for (int r = 0; r < 16; ++r) rli[r] = __builtin_amdgcn_rcpf(li_l[crow(r, hi)]);
    bf16_t* Ow = O + (rowbase + q0 + wid * QBLK) * DM + h * DV;
#pragma unroll
    for (int r = 0; r < 16; ++r) { const int orow = crow(r, hi);
#pragma unroll
        for (int d0 = 0; d0 < 4; ++d0) { const float v = o[d0][r] * rli[r]; const float vn = __shfl_xor(v, 1);
            if ((r32 & 1) == 0) *(unsigned*)(Ow + (size_t)orow * DM + d0 * 32 + r32) = cvtpk(v, vn); } }
    __syncthreads();
#undef SLOAD
#undef SWRITE
}
#undef SBAR
}
using pg8::Gemm; using pg8::StaticOrder; using pg8::gemm_phase;
#define LDS_WAIT() asm volatile("s_waitcnt lgkmcnt(0)" ::: "memory")
constexpr int NWAVES = 8, NTHREADS = 512;
constexpr int LDS_BYTES = 135168;

__device__ __forceinline__ float wave_sum(float v) {
#pragma unroll
    for (int o = 1; o < 64; o <<= 1) v += __shfl_xor(v, o);
    return v;
}
__device__ __forceinline__ unsigned pk2(float lo, float hi) { return pg8::cvt_pk_bf16(lo, hi); }
__device__ __forceinline__ float bflo(unsigned u) { return __uint_as_float(u << 16); }
__device__ __forceinline__ float bfhi(unsigned u) { return __uint_as_float(u & 0xffff0000u); }
__device__ __forceinline__ void unpack8(const u32x4 w, float* f) { f[0] = bflo(w.x); f[1] = bfhi(w.x); f[2] = bflo(w.y); f[3] = bfhi(w.y); f[4] = bflo(w.z); f[5] = bfhi(w.z); f[6] = bflo(w.w); f[7] = bfhi(w.w); }
__device__ __forceinline__ u32x4 pack8f(const float* f) { u32x4 w; w.x = pk2(f[0], f[1]); w.y = pk2(f[2], f[3]); w.z = pk2(f[4], f[5]); w.w = pk2(f[6], f[7]); return w; }

template <int MAP> __device__ __forceinline__ int wmap(int n) {
    if (MAP == 1) { return n < 1280 ? n : (n < 1344 ? n + (PC_KR - 1280) : n - 64); }
    if (MAP == 2) { const int h = n / 192, w = n - h * 192; if (w < 128) return n; const int j = w - 128;
                    return h * 192 + 128 + (j < 32 ? 2 * j : 2 * (j - 32) + 1); }
    if (MAP == 3) { if (n < DFF) return (n >> 7) * 256 + (n & 127); const int n2 = n - DFF; return (n2 >> 7) * 256 + 128 + (n2 & 127); }
    return n;
}
template <int MAP> __device__ __forceinline__ void transpose_item(const float* __restrict__ W, int K, int N, bf16_t* __restrict__ WT, LAS float* scr, int item, int lane) {
    const int nblk = N / 32, kb = item / nblk, nb = item - kb * nblk, k0 = 64 * kb, n0 = 32 * nb;
#pragma unroll 8
    for (int i = 0; i < 32; ++i) { const int kk = 2 * i + (lane >> 5); scr[kk * 33 + (lane & 31)] = W[(size_t)(k0 + kk) * N + n0 + (lane & 31)]; }
    LDS_WAIT(); asm volatile("" ::: "memory");
    const int c = lane & 7;
#pragma unroll
    for (int j = 0; j < 4; ++j) { const int n = (lane >> 3) + 8 * j; const LAS float* s = scr + (8 * c) * 33 + n;
        u32x4 o; o.x = pk2(s[0 * 33], s[1 * 33]); o.y = pk2(s[2 * 33], s[3 * 33]); o.z = pk2(s[4 * 33], s[5 * 33]); o.w = pk2(s[6 * 33], s[7 * 33]);
        *(u32x4*)(WT + (size_t)wmap<MAP>(n0 + n) * K + k0 + 8 * c) = o; }
    LDS_WAIT(); asm volatile("" ::: "memory");
}

struct Args {
    const float* x; const float* c; const int* pos; const float* w_ada; const float* b_ada; const float* g_pre_mix; const float* g_post_mix;
    const float* w_in; const float* g_q; const float* w_uq; const float* g_kv; const float* w_ukv; const float* conv_w_mix; const float* conv_b_mix;
    const float* w_o; const float* g_pre_ffn; const float* g_post_ffn; const float* w_up; const float* conv_w_ffn; const float* conv_b_ffn; const float* w_down;
    float* out; unsigned char* ws;
};

__device__ __forceinline__ void ph_prologue(const Args& a, LAS unsigned char* lds, int G) {
    int tid_o = threadIdx.x; asm volatile("" : "+v"(tid_o)); const int tid = tid_o, lane = tid & 63, wave = tid >> 6;
    unsigned char* ws = a.ws;
    float* MOD = (float*)(ws + WS_MOD);
    for (int it = blockIdx.x; it < NMODC / 64; it += G) {
        LAS float* red = (LAS float*)lds;
        const int kg = tid >> 4, l16 = tid & 15, col = it * 64 + l16 * 4;
        f32x4 a0 = {0.f, 0.f, 0.f, 0.f}, a1 = {0.f, 0.f, 0.f, 0.f};
#pragma unroll 8
        for (int i = 0; i < 64; ++i) { const int k = kg + 32 * i;
            const f32x4 w = *(const f32x4*)(a.w_ada + (size_t)k * NMODC + col);
            const float c0 = a.c[k], c1 = a.c[DM + k];
            const float s0 = c0 / (1.f + __expf(-c0)), s1 = c1 / (1.f + __expf(-c1));
            a0 += w * s0; a1 += w * s1; }
        LAS float* rp = red + (kg * 16 + l16) * 8;
        rp[0] = a0[0]; rp[1] = a0[1]; rp[2] = a0[2]; rp[3] = a0[3]; rp[4] = a1[0]; rp[5] = a1[1]; rp[6] = a1[2]; rp[7] = a1[3];
        __syncthreads();
        if (tid < 128) { const int b = tid >> 6, cc = tid & 63; float s = 0.f;
            for (int g = 0; g < 32; ++g) s += red[(g * 16 + (cc >> 2)) * 8 + b * 4 + (cc & 3)];
            MOD[b * NMODC + it * 64 + cc] = s + a.b_ada[it * 64 + cc]; }
        __syncthreads();
    }
    LAS float* scr = (LAS float*)(lds + wave * 16384);
    const int gw = blockIdx.x * NWAVES + wave, NGW = G * NWAVES;
    bf16_t* WinT = (bf16_t*)(ws + WS_WIN); bf16_t* WuqT = (bf16_t*)(ws + WS_WUQ); bf16_t* WukvT = (bf16_t*)(ws + WS_WUKV);
    bf16_t* WoT = (bf16_t*)(ws + WS_WO); bf16_t* WupT = (bf16_t*)(ws + WS_WUP); bf16_t* WdnT = (bf16_t*)(ws + WS_WDN);
    constexpr int I_IN = (DM / 64) * (INC / 32), I_UQ = (QL / 64) * (NQ / 32), I_UKV = (KVL / 64) * (NKV / 32), I_O = (DM / 64) * (DM / 32), I_UP = (DM / 64) * (NUP / 32), I_DN = (DFF / 64) * (DM / 32);
    constexpr int NITEMS = I_IN + I_UQ + I_UKV + I_O + I_UP + I_DN;
    for (int it = gw; it < NITEMS; it += NGW) {
        int r = it;
        if (r < I_UP) { transpose_item<3>(a.w_up, DM, NUP, WupT, scr, r, lane); continue; } r -= I_UP;
        if (r < I_DN) { transpose_item<0>(a.w_down, DFF, DM, WdnT, scr, r, lane); continue; } r -= I_DN;
        if (r < I_IN) { transpose_item<1>(a.w_in, DM, INC, WinT, scr, r, lane); continue; } r -= I_IN;
        if (r < I_O) { transpose_item<0>(a.w_o, DM, DM, WoT, scr, r, lane); continue; } r -= I_O;
        if (r < I_UQ) { transpose_item<2>(a.w_uq, QL, NQ, WuqT, scr, r, lane); continue; } r -= I_UQ;
        transpose_item<0>(a.w_ukv, KVL, NKV, WukvT, scr, r, lane);
    }
    const int gt = blockIdx.x * NTHREADS + tid, NGT = G * NTHREADS;
    { u32x4* z = (u32x4*)(WinT + (size_t)INC * DM); const int nz = (INP - INC) * DM / 8;
      for (int i = gt; i < nz; i += NGT) z[i] = (u32x4){0u, 0u, 0u, 0u}; }
    { f32x2* CS = (f32x2*)(ws + WS_CS);
      for (int i = gt; i < M * 32; i += NGT) { const int row = i >> 5, j = i & 31;
          const float inv = 1.0f / exp2f((float)(2 * j) * (13.287712379549449f / 64.f));
          const float ang = (float)a.pos[row] * inv;
          const double rv = (double)ang * 0.15915494309189535; const float f = (float)(rv - __builtin_rint(rv));
          CS[i] = (f32x2){__builtin_amdgcn_cosf(f), __builtin_amdgcn_sinf(f)}; } }
}

__device__ __forceinline__ void ph_prenorm(const float* __restrict__ x, const float* __restrict__ g, const float* __restrict__ mod, int sh_i, int sc_i, bf16_t* __restrict__ XN, int gw, int NGW, int lane) {
    for (int row = gw; row < M; row += NGW) {
        const float* mb = mod + (row >= SEQ ? NMODC : 0);
        const f32x4* xr = (const f32x4*)(x + (size_t)row * DM) + lane;
        f32x4 v[8]; float ss = 0.f;
#pragma unroll
        for (int j = 0; j < 8; ++j) { v[j] = xr[64 * j]; ss += (v[j][0] * v[j][0] + v[j][1] * v[j][1]) + (v[j][2] * v[j][2] + v[j][3] * v[j][3]); }
        const float rstd = rsqrtf(wave_sum(ss) * (1.f / DM) + RMS_EPS);
#pragma unroll
        for (int j = 0; j < 8; ++j) { const int e = (lane + 64 * j) * 4;
            const f32x4 g4 = *(const f32x4*)(g + e), s4 = *(const f32x4*)(mb + sc_i * DM + e), h4 = *(const f32x4*)(mb + sh_i * DM + e);
            const f32x4 o = v[j] * rstd * g4 * (s4 + 1.f) + h4;
            *(u32x2*)(XN + (size_t)row * DM + e) = (u32x2){pk2(o[0], o[1]), pk2(o[2], o[3])}; }
    }
}

__device__ __forceinline__ void ph_mid(const Args& a, int gw, int NGW, int lane) {
    unsigned char* ws = a.ws;
    const bf16_t* PROJ = (const bf16_t*)(ws + WS_PROJ); const float* CS = (const float*)(ws + WS_CS);
    bf16_t* QN = (bf16_t*)(ws + WS_QN); bf16_t* KVN = (bf16_t*)(ws + WS_KVN); bf16_t* KR = (bf16_t*)(ws + WS_KR); bf16_t* MIXIN = (bf16_t*)(ws + WS_XN);
    for (int row = gw; row < M; row += NGW) {
        const bf16_t* pr = PROJ + (size_t)row * INP;
        {
            float f[3][4]; float ss = 0.f;
#pragma unroll
            for (int j = 0; j < 3; ++j) { const u32x2 w = *(const u32x2*)(pr + PC_Q + (lane + 64 * j) * 4);
                f[j][0] = bflo(w.x); f[j][1] = bfhi(w.x); f[j][2] = bflo(w.y); f[j][3] = bfhi(w.y);
                ss += (f[j][0] * f[j][0] + f[j][1] * f[j][1]) + (f[j][2] * f[j][2] + f[j][3] * f[j][3]); }
            const float rstd = rsqrtf(wave_sum(ss) * (1.f / QL) + RMS_EPS);
#pragma unroll
            for (int j = 0; j < 3; ++j) { const int e = (lane + 64 * j) * 4; const f32x4 g4 = *(const f32x4*)(a.g_q + e);
                *(u32x2*)(QN + (size_t)row * QL + e) = (u32x2){pk2(f[j][0] * rstd * g4[0], f[j][1] * rstd * g4[1]), pk2(f[j][2] * rstd * g4[2], f[j][3] * rstd * g4[3])}; }
        }
        {
            float f[8]; unpack8(*(const u32x4*)(pr + PC_KV + lane * 8), f); float ss = 0.f;
#pragma unroll
            for (int i = 0; i < 8; ++i) ss += f[i] * f[i];
            const float rstd = rsqrtf(wave_sum(ss) * (1.f / KVL) + RMS_EPS);
            const f32x4 g0 = *(const f32x4*)(a.g_kv + lane * 8), g1 = *(const f32x4*)(a.g_kv + lane * 8 + 4);
#pragma unroll
            for (int i = 0; i < 4; ++i) { f[i] *= rstd * g0[i]; f[4 + i] *= rstd * g1[i]; }
            *(u32x4*)(KVN + (size_t)row * KVL + lane * 8) = pack8f(f);
        }
        if (lane < 32) {
            const float x1 = __uint_as_float((unsigned)pr[PC_KR + lane] << 16), x2 = __uint_as_float((unsigned)pr[PC_KR + 32 + lane] << 16);
            const f32x2 cs = *(const f32x2*)(CS + (size_t)row * 64 + 2 * lane);
            *(unsigned*)(KR + (size_t)row * 64 + 2 * lane) = pk2(x1 * cs.x - x2 * cs.y, x2 * cs.x + x1 * cs.y);
        }
        const int tt = row & (SEQ - 1);
#pragma unroll
        for (int j = 0; j < 2; ++j) {
            const int c0 = lane * 8 + 512 * j;
            float gb[8], p0[8], p1[8], p2[8], t0[8], t1[8];
            unpack8(*(const u32x4*)(pr + PC_GB + c0), gb);
            unpack8(*(const u32x4*)(pr + PC_GC + c0), t0); unpack8(*(const u32x4*)(pr + PC_CI + c0), t1);
#pragma unroll
            for (int i = 0; i < 8; ++i) p0[i] = t0[i] * t1[i];
            if (tt >= 1) { unpack8(*(const u32x4*)(pr - INP + PC_GC + c0), t0); unpack8(*(const u32x4*)(pr - INP + PC_CI + c0), t1); }
#pragma unroll
            for (int i = 0; i < 8; ++i) p1[i] = tt >= 1 ? t0[i] * t1[i] : 0.f;
            if (tt >= 2) { unpack8(*(const u32x4*)(pr - 2 * INP + PC_GC + c0), t0); unpack8(*(const u32x4*)(pr - 2 * INP + PC_CI + c0), t1); }
#pragma unroll
            for (int i = 0; i < 8; ++i) p2[i] = tt >= 2 ? t0[i] * t1[i] : 0.f;
            float o[8];
#pragma unroll
            for (int i = 0; i < 8; ++i) { const float w0 = a.conv_w_mix[c0 + i], w1 = a.conv_w_mix[CW + c0 + i], w2 = a.conv_w_mix[2 * CW + c0 + i], bb = a.conv_b_mix[c0 + i];
                o[i] = gb[i] * (w0 * p2[i] + w1 * p1[i] + w2 * p0[i] + bb); }
            *(u32x4*)(MIXIN + (size_t)row * DM + CW + c0) = pack8f(o);
        }
    }
}

__device__ __forceinline__ void ph_post_mix(const Args& a, int gw, int NGW, int lane) {
    unsigned char* ws = a.ws; const float* MIX = (const float*)(ws + WS_PROJ); const float* mod = (const float*)(ws + WS_MOD); bf16_t* XN2 = (bf16_t*)(ws + WS_XN);
    for (int row = gw; row < M; row += NGW) {
        const float* mb = mod + (row >= SEQ ? NMODC : 0);
        const f32x4* mr = (const f32x4*)(MIX + (size_t)row * DM) + lane; const f32x4* xr = (const f32x4*)(a.x + (size_t)row * DM) + lane;
        f32x4 v[8]; float ss = 0.f;
#pragma unroll
        for (int j = 0; j < 8; ++j) { v[j] = mr[64 * j]; ss += (v[j][0] * v[j][0] + v[j][1] * v[j][1]) + (v[j][2] * v[j][2] + v[j][3] * v[j][3]); }
        const float rstd = rsqrtf(wave_sum(ss) * (1.f / DM) + RMS_EPS);
        float ss2 = 0.f;
#pragma unroll
        for (int j = 0; j < 8; ++j) { const int e = (lane + 64 * j) * 4;
            const f32x4 g4 = *(const f32x4*)(a.g_post_mix + e), gt = *(const f32x4*)(mb + 2 * DM + e);
            const f32x4 x1 = xr[64 * j] + gt * (v[j] * rstd * g4);
            *(f32x4*)(a.out + (size_t)row * DM + e) = x1; v[j] = x1;
            ss2 += (x1[0] * x1[0] + x1[1] * x1[1]) + (x1[2] * x1[2] + x1[3] * x1[3]); }
        const float rstd2 = rsqrtf(wave_sum(ss2) * (1.f / DM) + RMS_EPS);
#pragma unroll
        for (int j = 0; j < 8; ++j) { const int e = (lane + 64 * j) * 4;
            const f32x4 g4 = *(const f32x4*)(a.g_pre_ffn + e), s4 = *(const f32x4*)(mb + 4 * DM + e), h4 = *(const f32x4*)(mb + 3 * DM + e);
            const f32x4 o = v[j] * rstd2 * g4 * (s4 + 1.f) + h4;
            *(u32x2*)(XN2 + (size_t)row * DM + e) = (u32x2){pk2(o[0], o[1]), pk2(o[2], o[3])}; }
    }
}

__device__ __forceinline__ void ph_act(const Args& a, int t0, int ntiles, int gt, int NGT) {
    unsigned char* ws = a.ws; const bf16_t* U = (const bf16_t*)(ws + WS_U); bf16_t* ACT = (bf16_t*)(ws + WS_ACT);
    const int Np = ntiles * 256, nch = ntiles * 16, total = (M / 8) * nch;
    for (int idx = gt; idx < total; idx += NGT) {
        const int rb = idx / nch, ch = idx - rb * nch, tile = ch >> 4, cc = ch & 15;
        const int ucol = tile * 256 + cc * 8, acol = (t0 + tile) * 128 + cc * 8;
        float wa[3][8], wg[3][8], ba[8], bg[8];
#pragma unroll
        for (int k = 0; k < 3; ++k) {
            const f32x4 q0 = *(const f32x4*)(a.conv_w_ffn + k * NUP + acol), q1 = *(const f32x4*)(a.conv_w_ffn + k * NUP + acol + 4);
            const f32x4 r0 = *(const f32x4*)(a.conv_w_ffn + k * NUP + DFF + acol), r1 = *(const f32x4*)(a.conv_w_ffn + k * NUP + DFF + acol + 4);
#pragma unroll
            for (int i = 0; i < 4; ++i) { wa[k][i] = q0[i]; wa[k][4 + i] = q1[i]; wg[k][i] = r0[i]; wg[k][4 + i] = r1[i]; } }
        { const f32x4 q0 = *(const f32x4*)(a.conv_b_ffn + acol), q1 = *(const f32x4*)(a.conv_b_ffn + acol + 4);
          const f32x4 r0 = *(const f32x4*)(a.conv_b_ffn + DFF + acol), r1 = *(const f32x4*)(a.conv_b_ffn + DFF + acol + 4);
#pragma unroll
          for (int i = 0; i < 4; ++i) { ba[i] = q0[i]; ba[4 + i] = q1[i]; bg[i] = r0[i]; bg[4 + i] = r1[i]; } }
        const int r0w = rb * 8; const bool first = (r0w & (SEQ - 1)) == 0;
        float a1[8], a2[8], g1[8], g2[8];
#pragma unroll
        for (int i = 0; i < 8; ++i) { a1[i] = 0.f; a2[i] = 0.f; g1[i] = 0.f; g2[i] = 0.f; }
        if (!first) { const bf16_t* up = U + (size_t)(r0w - 2) * Np + ucol;
            unpack8(*(const u32x4*)up, a2); unpack8(*(const u32x4*)(up + 128), g2); unpack8(*(const u32x4*)(up + Np), a1); unpack8(*(const u32x4*)(up + Np + 128), g1); }
#pragma unroll
        for (int r = 0; r < 8; ++r) { const bf16_t* up = U + (size_t)(r0w + r) * Np + ucol;
            float a0[8], g0[8], o[8]; unpack8(*(const u32x4*)up, a0); unpack8(*(const u32x4*)(up + 128), g0);
#pragma unroll
            for (int i = 0; i < 8; ++i) { const float ua = wa[0][i] * a2[i] + wa[1][i] * a1[i] + wa[2][i] * a0[i] + ba[i];
                const float ug = wg[0][i] * g2[i] + wg[1][i] * g1[i] + wg[2][i] * g0[i] + bg[i];
                o[i] = ua * ug * __builtin_amdgcn_rcpf(1.f + __expf(-ug)); a2[i] = a1[i]; a1[i] = a0[i]; g2[i] = g1[i]; g1[i] = g0[i]; }
            *(u32x4*)(ACT + (size_t)(r0w + r) * DFF + acol) = pack8f(o); }
    }
}

__device__ __forceinline__ void ph_final(const Args& a, int gw, int NGW, int lane) {
    unsigned char* ws = a.ws; const float* Y = (const float*)(ws + WS_Y); const float* mod = (const float*)(ws + WS_MOD);
    for (int row = gw; row < M; row += NGW) {
        const float* mb = mod + (row >= SEQ ? NMODC : 0);
        const f32x4* yr = (const f32x4*)(Y + (size_t)row * DM) + lane;
        f32x4 v[8]; float ss = 0.f;
#pragma unroll
        for (int j = 0; j < 8; ++j) { v[j] = yr[64 * j]; ss += (v[j][0] * v[j][0] + v[j][1] * v[j][1]) + (v[j][2] * v[j][2] + v[j][3] * v[j][3]); }
        const float rstd = rsqrtf(wave_sum(ss) * (1.f / DM) + RMS_EPS);
#pragma unroll
        for (int j = 0; j < 8; ++j) { const int e = (lane + 64 * j) * 4;
            const f32x4 g4 = *(const f32x4*)(a.g_post_ffn + e), gt = *(const f32x4*)(mb + 5 * DM + e);
            f32x4* op = (f32x4*)(a.out + (size_t)row * DM + e);
            *op = *op + gt * (v[j] * rstd * g4); }
    }
}

__global__ void __launch_bounds__(NTHREADS, 2) mega_fwd(Args a) {
    extern __shared__ __attribute__((aligned(16))) unsigned char lds_raw[];
    cg::grid_group grid = cg::this_grid();
    LAS unsigned char* lds = (LAS unsigned char*)lds_raw;
    const int tid = threadIdx.x, lane = tid & 63, wave = __builtin_amdgcn_readfirstlane(tid >> 6);
    const int G = gridDim.x, bid = blockIdx.x;
    const int gw = bid * NWAVES + wave, NGW = G * NWAVES, gt = bid * NTHREADS + tid, NGT = G * NTHREADS;
    unsigned char* ws = a.ws;
    bf16_t* XN = (bf16_t*)(ws + WS_XN);

    ph_prologue(a, lds, G);
    grid.sync();
    ph_prenorm(a.x, a.g_pre_mix, (const float*)(ws + WS_MOD), 0, 1, XN, gw, NGW, lane);
    grid.sync();
    {
        Gemm g{XN, (const bf16_t*)(ws + WS_WIN), M, INP, DM}; StaticOrder S; S.init(M, INP, G, bid);
        pg8::EpiBf16 E{(bf16_t*)(ws + WS_PROJ), INP};
        gemm_phase<pg8::EpiBf16, StaticOrder, true, true>(lds, g, S, E);
    }
    grid.sync();
    ph_mid(a, gw, NGW, lane);
    grid.sync();
    {
        Gemm g{(const bf16_t*)(ws + WS_QN), (const bf16_t*)(ws + WS_WUQ), M, NQ, QL}; StaticOrder S; S.init(M, NQ, G, bid);
        pg8::EpiQ E{(bf16_t*)(ws + WS_Q), (const float*)(ws + WS_CS)};
        gemm_phase<pg8::EpiQ, StaticOrder, true, true>(lds, g, S, E);
        Gemm g2{(const bf16_t*)(ws + WS_KVN), (const bf16_t*)(ws + WS_WUKV), M, NKV, KVL}; StaticOrder S2; S2.init(M, NKV, G, bid);
        pg8::EpiBf16 E2{(bf16_t*)(ws + WS_KV), NKV};
        gemm_phase<pg8::EpiBf16, StaticOrder, true, true>(lds, g2, S2, E2);
    }
    grid.sync();
    {
        for (int L = bid; L < 256; L += G) {
            const int v = (L & 7) * 32 + (L >> 3), bh = v >> 4, s = v & 15;
            att::attn_unit(bh >> 3, bh & 7, 31 - s, (const bf16_t*)(ws + WS_Q), (const bf16_t*)(ws + WS_KV), (const bf16_t*)(ws + WS_KR), XN, (char*)lds_raw);
            att::attn_unit(bh >> 3, bh & 7, s, (const bf16_t*)(ws + WS_Q), (const bf16_t*)(ws + WS_KV), (const bf16_t*)(ws + WS_KR), XN, (char*)lds_raw);
        }
    }
    grid.sync();
    {
        Gemm g{XN, (const bf16_t*)(ws + WS_WO), M, DM, DM}; StaticOrder S; S.init(M, DM, G, bid);
        pg8::EpiF32 E{(float*)(ws + WS_PROJ), DM};
        gemm_phase<pg8::EpiF32, StaticOrder, true, true>(lds, g, S, E);
    }
    grid.sync();
    ph_post_mix(a, gw, NGW, lane);
    grid.sync();
    {
        Gemm g{XN, (const bf16_t*)(ws + WS_WUP), M, UP_TA * 256, DM}; StaticOrder S; S.init(M, UP_TA * 256, G, bid);
        pg8::EpiBf16 E{(bf16_t*)(ws + WS_U), UP_TA * 256};
        gemm_phase<pg8::EpiBf16, StaticOrder, true, true>(lds, g, S, E);
    }
    grid.sync();
    ph_act(a, 0, UP_TA, gt, NGT);
    grid.sync();
    {
        Gemm g{XN, (const bf16_t*)(ws + WS_WUP) + (size_t)UP_TA * 256 * DM, M, UP_TB * 256, DM}; StaticOrder S; S.init(M, UP_TB * 256, G, bid);
        pg8::EpiBf16 E{(bf16_t*)(ws + WS_U), UP_TB * 256};
        gemm_phase<pg8::EpiBf16, StaticOrder, true, true>(lds, g, S, E);
    }
    grid.sync();
    ph_act(a, UP_TA, UP_TB, gt, NGT);
    grid.sync();
    {
        Gemm g{(const bf16_t*)(ws + WS_ACT), (const bf16_t*)(ws + WS_WDN), M, DM, DFF}; StaticOrder S; S.init(M, DM, G, bid);
        pg8::EpiF32 E{(float*)(ws + WS_Y), DM};
        gemm_phase<pg8::EpiF32, StaticOrder, true, true>(lds, g, S, E);
    }
    grid.sync();
    ph_final(a, gw, NGW, lane);
}

extern "C" void kernel_launch(void* const* d_in, const int* in_sizes, int n_in, void* d_out, int out_size, void* d_ws, size_t ws_size, hipStream_t stream) {
    static int grid = 0;
    if (grid == 0) {
        if (n_in != 21 || in_sizes[0] != M * DM || out_size != M * DM || ws_size < WS_END) {
            fprintf(stderr, "kernel_launch: unexpected shapes (n_in %d, in0 %d, out %d, ws %zu; need ws >= %zu)\n", n_in, n_in > 0 ? in_sizes[0] : -1, out_size, ws_size, (size_t)WS_END); grid = -1; return; }
        int dev = 0, cus = 0, per_cu = 0;
        (void)hipGetDevice(&dev);
        (void)hipDeviceGetAttribute(&cus, hipDeviceAttributeMultiprocessorCount, dev);
        if (hipFuncSetAttribute((const void*)mega_fwd, hipFuncAttributeMaxDynamicSharedMemorySize, LDS_BYTES) != hipSuccess) { fprintf(stderr, "kernel_launch: hipFuncSetAttribute failed\n"); grid = -1; return; }
        if (hipOccupancyMaxActiveBlocksPerMultiprocessor(&per_cu, (const void*)mega_fwd, NTHREADS, LDS_BYTES) != hipSuccess || per_cu < 1) { fprintf(stderr, "kernel_launch: occupancy query failed (%d)\n", per_cu); (void)hipGetLastError(); per_cu = 1; }
        grid = cus * per_cu;
        fprintf(stderr, "kernel_launch: %d CUs x %d workgroups\n", cus, per_cu);
    }
    if (grid < 0) return;
    Args a{};
    a.x = (const float*)d_in[0]; a.c = (const float*)d_in[1]; a.pos = (const int*)d_in[2]; a.w_ada = (const float*)d_in[3]; a.b_ada = (const float*)d_in[4];
    a.g_pre_mix = (const float*)d_in[5]; a.g_post_mix = (const float*)d_in[6]; a.w_in = (const float*)d_in[7]; a.g_q = (const float*)d_in[8]; a.w_uq = (const float*)d_in[9];
    a.g_kv = (const float*)d_in[10]; a.w_ukv = (const float*)d_in[11]; a.conv_w_mix = (const float*)d_in[12]; a.conv_b_mix = (const float*)d_in[13]; a.w_o = (const float*)d_in[14];
    a.g_pre_ffn = (const float*)d_in[15]; a.g_post_ffn = (const float*)d_in[16]; a.w_up = (const float*)d_in[17]; a.conv_w_ffn = (const float*)d_in[18]; a.conv_b_ffn = (const float*)d_in[19];
    a.w_down = (const float*)d_in[20]; a.out = (float*)d_out; a.ws = (unsigned char*)d_ws;
    void* args[] = {&a};
    hipError_t e = hipLaunchCooperativeKernel((const void*)mega_fwd, dim3(grid), dim3(NTHREADS), args, LDS_BYTES, stream);
    if (e != hipSuccess) fprintf(stderr, "kernel_launch: cooperative launch failed: %s (grid %d)\n", hipGetErrorString(e), grid);
}
```

```cpp
#include <hip/hip_runtime.h>
#include <hip/hip_cooperative_groups.h>
#include <cstdio>
#include <cstdint>
namespace cg = cooperative_groups;

constexpr int BATCH = 2, SEQ = 8192, DM = 2048, M = BATCH * SEQ;
constexpr int QL = 768, KVL = 512, ROPE = 64, CW = 1024, INC = 4416, INP = 4608;
constexpr int NH = 8, DQK = 192, NQ = NH * DQK  , NKV = NH * 256  ;
constexpr int DFF = 5632, NUP = 2 * DFF;
constexpr int NMODC = 6 * DM;
constexpr float RMS_EPS = 1e-6f;
constexpr int PC_Q = 0, PC_KV = 768, PC_GB = 1280, PC_GC = 2304, PC_CI = 3328, PC_KR = 4352;
constexpr int UP_TA = 20, UP_TB = 24;

constexpr size_t MiB = 1u << 20;
constexpr size_t WS_WUP = 0, WS_WDN = 44 * MiB, WS_MOD = 66 * MiB;
constexpr size_t WS_XN = 68 * MiB;
constexpr size_t WS_WIN = 132 * MiB, WS_WUQ = 150 * MiB, WS_WUKV = 153 * MiB, WS_WO = 155 * MiB, WS_CS = 163 * MiB;
constexpr size_t WS_PROJ = 168 * MiB;
constexpr size_t WS_QN = 312 * MiB, WS_KVN = 336 * MiB, WS_KR = 352 * MiB, WS_Q = 354 * MiB, WS_KV = 402 * MiB;
constexpr size_t WS_U = 132 * MiB;
constexpr size_t WS_ACT = 324 * MiB;
constexpr size_t WS_Y = 132 * MiB;
constexpr size_t WS_END = 500 * MiB;

#define LAS __attribute__((address_space(3)))
typedef unsigned u32x4 __attribute__((ext_vector_type(4)));
typedef unsigned u32x2 __attribute__((ext_vector_type(2)));
typedef float f32x2 __attribute__((ext_vector_type(2)));
typedef unsigned short bf16_t;
typedef short bf16x8 __attribute__((ext_vector_type(8)));
typedef short s16x4 __attribute__((ext_vector_type(4)));
typedef float f32x4 __attribute__((ext_vector_type(4)));
typedef float f32x16 __attribute__((ext_vector_type(16)));
namespace pg8 {
#define PG8_LAS __attribute__((address_space(3)))
typedef unsigned short bf16_t;
typedef short bf16x8 __attribute__((ext_vector_type(8)));
typedef float f32x4 __attribute__((ext_vector_type(4)));
typedef unsigned u32x4 __attribute__((ext_vector_type(4)));
constexpr int BM = 256, BK = 64, HALF = 128, HTB = HALF * BK * 2  , STAGE_BYTES = 8 * HTB, NXCD = 8, WGM = 8;

__host__ __device__ __forceinline__ int lds_byte(int r, int c) { const int st = (r >> 4) * 2 + (c >> 5), rr = r & 15, cc = c & 31, ob = rr * 64 + cc * 2; return st * 1024 + (ob ^ (((ob >> 9) & 1) << 5)); }
__host__ __device__ __forceinline__ void stage_rc(int b, int& R, int& C) { const int st = b / 1024, sb = b % 1024, swz = sb ^ (((sb >> 9) & 1) << 5); R = (st >> 1) * 16 + swz / 64; C = (st & 1) * 32 + (swz % 64) / 2; }
__host__ __device__ __forceinline__ int perm32(int rho) { const int n = rho >> 4, i = rho & 15; return 8 * (i >> 2) + 4 * n + (i & 3); }

struct Unit { int pm, pn; };
struct Gemm { const bf16_t* A; const bf16_t* Bt; int M, N, K; };

struct StaticOrder {
    int nM, nN, nwg, G, c;
    __host__ __device__ void init(int M, int N, int G_, int c_) { nM = M / BM; nN = N / BM; nwg = nM * nN; G = G_; c = c_; }
    __host__ __device__ bool next(int i, Unit& u) const {
        const long L = (long)i * G + c; if (L >= nwg) return false;
        int wgid = (int)L; { const int q = nwg / NXCD, r = nwg % NXCD, xcd = wgid % NXCD, off = wgid / NXCD; wgid = (xcd < r ? xcd * (q + 1) : r * (q + 1) + (xcd - r) * q) + off; }
        const int nig = WGM * nN, gid = wgid / nig, fm = gid * WGM, gsz = (nM - fm) < WGM ? (nM - fm) : WGM;
        u.pm = fm + ((wgid % nig) % gsz); u.pn = (wgid % nig) / gsz; return true;
    }
    __device__ __forceinline__ void a_ready(const Unit&) const {}
    __device__ __forceinline__ void done(const Unit&) const {}
};

__device__ __forceinline__ unsigned cvt_pk_bf16(float lo, float hi) { unsigned r; asm volatile("v_cvt_pk_bf16_f32 %0, %1, %2" : "=v"(r) : "v"(lo), "v"(hi)); return r; }
struct EpiBf16 {
    static constexpr bool PERM = true, AFTER_DRAIN = false;
    bf16_t* O; int ldc;
    __device__ __forceinline__ void operator()(const f32x4 (&acc)[2][2][4][2], const Unit& u, int wr, int wc, int fr, int fq) const {
        const int row0 = u.pm * BM + wr * 64 + fr, col0 = u.pn * BM + wc * 32 + 8 * fq;
#pragma unroll
        for (int ai = 0; ai < 2; ++ai)
#pragma unroll
            for (int m = 0; m < 4; ++m) { bf16_t* rowp = O + (size_t)(row0 + ai * HALF + m * 16) * ldc + col0;
#pragma unroll
                for (int bj = 0; bj < 2; ++bj) { const f32x4 v0 = acc[ai][bj][m][0], v1 = acc[ai][bj][m][1];
                    u32x4 w; w.x = cvt_pk_bf16(v0[0], v0[1]); w.y = cvt_pk_bf16(v0[2], v0[3]); w.z = cvt_pk_bf16(v1[0], v1[1]); w.w = cvt_pk_bf16(v1[2], v1[3]);
                    *(u32x4*)(rowp + bj * HALF) = w; } }
    }
};
struct EpiF32 {
    static constexpr bool PERM = true, AFTER_DRAIN = false;
    float* O; int ldc;
    __device__ __forceinline__ void operator()(const f32x4 (&acc)[2][2][4][2], const Unit& u, int wr, int wc, int fr, int fq) const {
        const int row0 = u.pm * BM + wr * 64 + fr, col0 = u.pn * BM + wc * 32 + 8 * fq;
#pragma unroll
        for (int ai = 0; ai < 2; ++ai)
#pragma unroll
            for (int m = 0; m < 4; ++m) { float* rowp = O + (size_t)(row0 + ai * HALF + m * 16) * ldc + col0;
#pragma unroll
                for (int bj = 0; bj < 2; ++bj) { *(f32x4*)(rowp + bj * HALF) = acc[ai][bj][m][0]; *(f32x4*)(rowp + bj * HALF + 4) = acc[ai][bj][m][1]; } }
    }
};
struct EpiQ {
    static constexpr bool PERM = true, AFTER_DRAIN = false;
    bf16_t* O; const float* CS;
    __device__ __forceinline__ void operator()(const f32x4 (&acc)[2][2][4][2], const Unit& u, int wr, int wc, int fr, int fq) const {
        const int row0 = u.pm * BM + wr * 64 + fr;
#pragma unroll
        for (int bj = 0; bj < 2; ++bj) {
            const int cb = u.pn * BM + bj * HALF + wc * 32, within = cb % 192; const bool rope = within >= 128;
            const int j0 = ((within - 128) >> 1) + 4 * fq;
#pragma unroll
            for (int ai = 0; ai < 2; ++ai)
#pragma unroll
                for (int m = 0; m < 4; ++m) { const int row = row0 + ai * HALF + m * 16;
                    f32x4 v0 = acc[ai][bj][m][0], v1 = acc[ai][bj][m][1];
                    if (rope) { const f32x4 c0 = *(const f32x4*)(CS + (size_t)row * 64 + j0 * 2), c1 = *(const f32x4*)(CS + (size_t)row * 64 + j0 * 2 + 4);
                        f32x4 a, b;
                        a[0] = v0[0] * c0[0] - v0[1] * c0[1]; a[1] = v0[1] * c0[0] + v0[0] * c0[1]; a[2] = v0[2] * c0[2] - v0[3] * c0[3]; a[3] = v0[3] * c0[2] + v0[2] * c0[3];
                        b[0] = v1[0] * c1[0] - v1[1] * c1[1]; b[1] = v1[1] * c1[0] + v1[0] * c1[1]; b[2] = v1[2] * c1[2] - v1[3] * c1[3]; b[3] = v1[3] * c1[2] + v1[2] * c1[3];
                        v0 = a; v1 = b; }
                    u32x4 w; w.x = cvt_pk_bf16(v0[0], v0[1]); w.y = cvt_pk_bf16(v0[2], v0[3]); w.z = cvt_pk_bf16(v1[0], v1[1]); w.w = cvt_pk_bf16(v1[2], v1[3]);
                    *(u32x4*)(O + (size_t)row * NQ + cb + 8 * fq) = w; }
        }
    }
};
template <class Epi, class Sched, bool ALIGN_EPI = false, bool SP2 = false>
__device__ __forceinline__ void gemm_phase(PG8_LAS unsigned char* lds, const Gemm g, const Sched& S, const Epi& E) {
    int tid_o = threadIdx.x; asm volatile("" : "+v"(tid_o)); const int tid = tid_o, wid = __builtin_amdgcn_readfirstlane(tid >> 6), lane = tid & 63, wr = wid >> 2, wc = wid & 3, fr = lane & 15, fq = lane >> 4;
    const int K = g.K, nt = K / BK;
    unsigned voffA[2], voffB[2];
#pragma unroll
    for (int i = 0; i < 2; ++i) { int R, C; stage_rc(tid * 16 + i * 8192, R, C); const int Rb = Epi::PERM ? ((R & ~31) + perm32(R & 31)) : R;
        voffA[i] = (unsigned)(R * K + C) * 2u; voffB[i] = (unsigned)(Rb * K + C) * 2u; }
    const size_t kstep = (size_t)(BK * 2);
    const size_t hstep = (size_t)HALF * K * 2;
    const size_t tstep = 2 * hstep;
    const unsigned ldsw = (unsigned)wid * 1024u;
    const int aoff = lds_byte(wr * 64 + fr, fq * 8), boff = lds_byte(wc * 32 + fr, fq * 8);
#define PG8_SA(b, h) (((b) * 2 + (h)) * HTB)
#define PG8_SB(b, h) ((4 + (b) * 2 + (h)) * HTB)
#define PG8_STAGE(bufoff, gbase, voff) do { _Pragma("unroll") for (int _i = 0; _i < 2; ++_i) \
        __builtin_amdgcn_global_load_lds((const unsigned*)((const char*)(gbase) + (voff)[_i]), (PG8_LAS unsigned*)(lds + (bufoff) + ldsw + _i * 8192), 16, 0, 0); } while (0)
#define PG8_LDA(dst, b, h) do { _Pragma("unroll") for (int m = 0; m < 4; ++m) _Pragma("unroll") for (int k = 0; k < 2; ++k) dst[m][k] = *(const PG8_LAS bf16x8*)(lds + PG8_SA(b, h) + aoff + m * 2048 + k * 1024); } while (0)
#define PG8_LDB(dst, b, h) do { _Pragma("unroll") for (int n = 0; n < 2; ++n) _Pragma("unroll") for (int k = 0; k < 2; ++k) dst[n][k] = *(const PG8_LAS bf16x8*)(lds + PG8_SB(b, h) + boff + n * 2048 + k * 1024); } while (0)
#define PG8_MMA(ai, bj, At, Bt) do { __builtin_amdgcn_s_setprio(1); _Pragma("unroll") for (int m = 0; m < 4; ++m) _Pragma("unroll") for (int n = 0; n < 2; ++n) _Pragma("unroll") for (int k = 0; k < 2; ++k) \
        acc[ai][bj][m][n] = __builtin_amdgcn_mfma_f32_16x16x32_bf16(Bt[n][k], At[m][k], acc[ai][bj][m][n], 0, 0, 0); __builtin_amdgcn_s_setprio(0); } while (0)
#define PG8_WAIT_V(n) asm volatile("s_waitcnt vmcnt(" #n ")" ::: "memory")
#define PG8_WAIT_L(n) asm volatile("s_waitcnt lgkmcnt(" #n ")" ::: "memory")
#define PG8_BAR __builtin_amdgcn_s_barrier()
#define PG8_SCHED __builtin_amdgcn_sched_barrier(0)
    Unit cur, nxt; int ui = 0;
    if (!S.next(0, cur)) return;
    f32x4 acc[2][2][4][2];
#pragma unroll
    for (int a = 0; a < 2; ++a)
#pragma unroll
        for (int b = 0; b < 2; ++b)
#pragma unroll
            for (int m = 0; m < 4; ++m)
#pragma unroll
                for (int n = 0; n < 2; ++n) acc[a][b][m][n] = (f32x4){0.f, 0.f, 0.f, 0.f};
    bf16x8 At[4][2], B0[2][2], B1[2][2];
    const char* cA = (const char*)g.A + (size_t)cur.pm * tstep; const char* cB = (const char*)g.Bt + (size_t)cur.pn * tstep;
    S.a_ready(cur);
    if constexpr (SP2) {
        PG8_STAGE(PG8_SB(0, 0), cB, voffB); PG8_STAGE(PG8_SB(0, 1), cB + hstep, voffB); PG8_STAGE(PG8_SA(0, 0), cA, voffA); PG8_STAGE(PG8_SA(0, 1), cA + hstep, voffA);
        if (wr == 1) PG8_BAR;
        PG8_WAIT_V(2); PG8_BAR;
        PG8_STAGE(PG8_SB(1, 0), cB + kstep, voffB); PG8_STAGE(PG8_SA(1, 0), cA + kstep, voffA); PG8_STAGE(PG8_SB(1, 1), cB + hstep + kstep, voffB);
        PG8_WAIT_V(6); PG8_BAR;
    } else {
        PG8_STAGE(PG8_SB(0, 0), cB, voffB); PG8_STAGE(PG8_SA(0, 0), cA, voffA); PG8_STAGE(PG8_SB(0, 1), cB + hstep, voffB); PG8_STAGE(PG8_SA(0, 1), cA + hstep, voffA);
        if (wr == 1) PG8_BAR;
        PG8_WAIT_V(4); PG8_BAR;
        PG8_STAGE(PG8_SB(1, 0), cB + kstep, voffB); PG8_STAGE(PG8_SA(1, 0), cA + kstep, voffA); PG8_STAGE(PG8_SB(1, 1), cB + hstep + kstep, voffB);
        PG8_WAIT_V(6); PG8_BAR;
    }
    for (;;) {
        const bool has_next = S.next(ui + 1, nxt);
        const char* nA = has_next ? (const char*)g.A + (size_t)nxt.pm * tstep : cA; const char* nB = has_next ? (const char*)g.Bt + (size_t)nxt.pn * tstep : cB;
        for (int t = 0; t < nt; t += 2) {
            const bool last = (t == nt - 2);
            const char* a1 = cA + (size_t)(t + 1) * kstep;
            const char* a2 = last ? nA : cA + (size_t)(t + 2) * kstep; const char* b2 = last ? nB : cB + (size_t)(t + 2) * kstep;
            const char* a3 = a2 + kstep; const char* b3 = b2 + kstep;
            if (last && has_next) S.a_ready(nxt);
            if constexpr (SP2) {
            PG8_LDB(B0, 0, 0); PG8_LDB(B1, 0, 1); PG8_SCHED; PG8_LDA(At, 0, 0); PG8_STAGE(PG8_SA(1, 1), a1 + hstep, voffA);
            PG8_WAIT_V(8); PG8_WAIT_L(0); PG8_BAR; PG8_MMA(0, 0, At, B0); PG8_MMA(0, 1, At, B1); PG8_BAR; PG8_SCHED;
            PG8_LDA(At, 0, 1); PG8_STAGE(PG8_SB(0, 0), b2, voffB); PG8_STAGE(PG8_SB(0, 1), b2 + hstep, voffB); PG8_STAGE(PG8_SA(0, 0), a2, voffA);
            PG8_WAIT_V(8); PG8_WAIT_L(0); PG8_BAR; PG8_MMA(1, 0, At, B0); PG8_MMA(1, 1, At, B1); PG8_BAR; PG8_SCHED;
            PG8_LDB(B0, 1, 0); PG8_LDB(B1, 1, 1); PG8_SCHED; PG8_LDA(At, 1, 0); PG8_STAGE(PG8_SA(0, 1), a2 + hstep, voffA);
            PG8_WAIT_V(8); PG8_WAIT_L(0); PG8_BAR; PG8_MMA(0, 0, At, B0); PG8_MMA(0, 1, At, B1); PG8_BAR; PG8_SCHED;
            PG8_LDA(At, 1, 1); PG8_STAGE(PG8_SB(1, 0), b3, voffB); PG8_STAGE(PG8_SB(1, 1), b3 + hstep, voffB); PG8_STAGE(PG8_SA(1, 0), a3, voffA);
            PG8_WAIT_V(8); PG8_WAIT_L(0); PG8_BAR; PG8_MMA(1, 0, At, B0); PG8_MMA(1, 1, At, B1); PG8_BAR; PG8_SCHED;
            } else {
            PG8_LDB(B0, 0, 0); PG8_SCHED; PG8_LDA(At, 0, 0); PG8_STAGE(PG8_SA(1, 1), a1 + hstep, voffA);
            PG8_WAIT_L(8); PG8_BAR; PG8_WAIT_L(0); PG8_MMA(0, 0, At, B0); PG8_BAR; PG8_SCHED;
            PG8_LDB(B1, 0, 1); PG8_STAGE(PG8_SB(0, 0), b2, voffB);
            PG8_BAR; PG8_WAIT_L(0); PG8_MMA(0, 1, At, B1); PG8_BAR;
            PG8_LDA(At, 0, 1); PG8_STAGE(PG8_SA(0, 0), a2, voffA);
            PG8_BAR; PG8_WAIT_L(0); PG8_MMA(1, 0, At, B0); PG8_BAR; PG8_SCHED;
            PG8_STAGE(PG8_SB(0, 1), b2 + hstep, voffB);
            PG8_WAIT_V(6); PG8_BAR; PG8_MMA(1, 1, At, B1); PG8_BAR;
            PG8_LDB(B0, 1, 0); PG8_SCHED; PG8_LDA(At, 1, 0); PG8_STAGE(PG8_SA(0, 1), a2 + hstep, voffA);
            PG8_WAIT_L(8); PG8_BAR; PG8_WAIT_L(0); PG8_MMA(0, 0, At, B0); PG8_BAR; PG8_SCHED;
            PG8_LDB(B1, 1, 1); PG8_STAGE(PG8_SB(1, 0), b3, voffB);
            PG8_BAR; PG8_WAIT_L(0); PG8_MMA(0, 1, At, B1); PG8_BAR;
            PG8_LDA(At, 1, 1); PG8_STAGE(PG8_SA(1, 0), a3, voffA);
            PG8_BAR; PG8_WAIT_L(0); PG8_MMA(1, 0, At, B0); PG8_BAR; PG8_SCHED;
            PG8_STAGE(PG8_SB(1, 1), b3 + hstep, voffB);
            PG8_WAIT_V(6); PG8_BAR; PG8_MMA(1, 1, At, B1); PG8_BAR;
            }
        }
        if constexpr (ALIGN_EPI) { if (wr == 0) PG8_BAR; }
        if constexpr (!Epi::AFTER_DRAIN) { E(acc, cur, wr, wc, fr, fq); S.done(cur); }
        if (!has_next) break;
#pragma unroll
        for (int a = 0; a < 2; ++a)
#pragma unroll
            for (int b = 0; b < 2; ++b)
#pragma unroll
                for (int m = 0; m < 4; ++m)
#pragma unroll
                    for (int n = 0; n < 2; ++n) acc[a][b][m][n] = (f32x4){0.f, 0.f, 0.f, 0.f};
        cur = nxt; cA = nA; cB = nB; ++ui;
        if constexpr (ALIGN_EPI) { if (wr == 1) PG8_BAR; }
    }
    PG8_WAIT_V(0);
    if constexpr (!ALIGN_EPI) { if (wr == 0) PG8_BAR; }
    PG8_BAR;
    if constexpr (Epi::AFTER_DRAIN) { E.fused(acc, cur, wr, wc, fr, fq, lds, wid, lane); S.done(cur); }
#undef PG8_SA
#undef PG8_SB
#undef PG8_STAGE
#undef PG8_LDA
#undef PG8_LDB
#undef PG8_MMA
#undef PG8_WAIT_V
#undef PG8_WAIT_L
#undef PG8_BAR
#undef PG8_SCHED
}
}
namespace att {
constexpr int NW = 8, QBLK = 32, KVBLK = 64, QB = NW * QBLK, DV = 128;
constexpr int KROW = 400;
constexpr int SHM_K = KVBLK * KROW, SHM_V = KVBLK * DV * 2;
constexpr int OFF_V = 0, OFF_K = 2 * SHM_V, OFF_WS = OFF_K + 2 * SHM_K, LDS_BYTES = OFF_WS + NW * 64 * 4;
constexpr float SCALE = 0.07216878364870322f;
constexpr float THR = 8.f;
#define SBAR() __builtin_amdgcn_sched_barrier(0)
__device__ __forceinline__ int v_st(int k, int c) { const int kk = (k & ~0xC) | ((k & 4) << 1) | ((k & 8) >> 1); return ((kk >> 3) * 4 + (c >> 5)) * 512 + ((kk & 7) * 32 + (c & 31)) * 2; }
__device__ __forceinline__ int v_rd_base(int lane) { return ((lane & 3) << 3) | (((lane >> 2) & 3) << 6) | (((lane >> 4) & 1) << 5) | (((lane >> 5) & 1) << 8); }
constexpr int v_rd_off(int d0, int ks, int half) { return d0 * 512 + ks * 4096 + half * 2048; }
__device__ __forceinline__ int crow(int r, int hi) { return (r & 3) + 8 * (r >> 2) + 4 * hi; }
__device__ __forceinline__ unsigned cvtpk(float lo, float hi) { unsigned r; asm volatile("v_cvt_pk_bf16_f32 %0, %1, %2" : "=v"(r) : "v"(lo), "v"(hi)); return r; }
__device__ __forceinline__ void mask_tile(f32x16& p0, f32x16& p1, int dq) {
    const float NEG = -__builtin_inff();
#pragma unroll
    for (int r = 0; r < 16; ++r) { const int c = (r & 3) + 8 * (r >> 2);
        if (dq - c < 0) p0[r] = NEG;
        if (dq - c - 32 < 0) p1[r] = NEG; }
}
__device__ __forceinline__ void partialSM(f32x16& p0, f32x16& p1, float& m_reg, float& mn, float& alpha) {
    float pmax = p0[0];
#pragma unroll
    for (int r = 1; r < 16; ++r) pmax = fmaxf(pmax, p0[r]);
#pragma unroll
    for (int r = 0; r < 16; ++r) pmax = fmaxf(pmax, p1[r]);
    { auto rr = __builtin_amdgcn_permlane32_swap(__float_as_uint(pmax), __float_as_uint(pmax), false, false);
      pmax = fmaxf(__uint_as_float(rr[0]), __uint_as_float(rr[1])); }
    constexpr float C2 = 1.4426950408889634f * SCALE;
    if (__builtin_expect(__all((pmax - m_reg) * SCALE <= THR), 1)) { mn = m_reg; alpha = 1.f; }
    else { mn = fmaxf(m_reg, pmax); alpha = __builtin_amdgcn_exp2f((m_reg - mn) * C2); m_reg = mn; }
    const float mnL = -mn * C2;
#pragma unroll
    for (int r = 0; r < 16; ++r) p0[r] = fmaf(p0[r], C2, mnL);
#pragma unroll
    for (int r = 0; r < 16; ++r) p1[r] = fmaf(p1[r], C2, mnL);
#pragma unroll
    for (int r = 0; r < 16; ++r) p0[r] = __builtin_amdgcn_exp2f(p0[r]);
}
__device__ __forceinline__ void finishSM(f32x16& p0, f32x16& p1, float alpha, float& l_reg, bf16x8& pa0, bf16x8& pa1, bf16x8& pa2, bf16x8& pa3) {
#pragma unroll
    for (int r = 0; r < 16; ++r) p1[r] = __builtin_amdgcn_exp2f(p1[r]);
    float ps = 0;
#pragma unroll
    for (int r = 0; r < 16; ++r) ps += p0[r];
#pragma unroll
    for (int r = 0; r < 16; ++r) ps += p1[r];
    { auto rr = __builtin_amdgcn_permlane32_swap(__float_as_uint(ps), __float_as_uint(ps), false, false);
      ps = __uint_as_float(rr[0]) + __uint_as_float(rr[1]); }
    l_reg = l_reg * alpha + ps;
#define PK4(P, B_, OUT) do { unsigned a0 = cvtpk(P[B_+0], P[B_+1]), a1 = cvtpk(P[B_+2], P[B_+3]);                          \
        unsigned b0 = cvtpk(P[B_+4], P[B_+5]), b1 = cvtpk(P[B_+6], P[B_+7]);                                             \
        auto r0 = __builtin_amdgcn_permlane32_swap(a0, b0, false, false); auto r1 = __builtin_amdgcn_permlane32_swap(a1, b1, false, false); \
        u32x4 w = {r0[0], r1[0], r0[1], r1[1]}; OUT = *reinterpret_cast<bf16x8*>(&w); } while (0)
    PK4(p0, 0, pa0); PK4(p0, 8, pa1); PK4(p1, 0, pa2); PK4(p1, 8, pa3);
#undef PK4
}
__device__ __forceinline__ void qkt(f32x16& p0, f32x16& p1, const char* Kb, int r32, int hi, const bf16x8* qr) {
    p0 = f32x16{}; p1 = f32x16{};
    const char* a = Kb + r32 * KROW + hi * 16;
#pragma unroll
    for (int d0 = 0; d0 < 12; ++d0) {
        const bf16x8 b0 = *reinterpret_cast<const bf16x8*>(a + d0 * 32);
        const bf16x8 b1 = *reinterpret_cast<const bf16x8*>(a + d0 * 32 + 32 * KROW);
        p0 = __builtin_amdgcn_mfma_f32_32x32x16_bf16(b0, qr[d0], p0, 0, 0, 0);
        p1 = __builtin_amdgcn_mfma_f32_32x32x16_bf16(b1, qr[d0], p1, 0, 0, 0); }
}
__device__ __forceinline__ void pv_tile(f32x16* o, int vb0, bf16x8 pa0, bf16x8 pa1, bf16x8 pa2, bf16x8 pa3) {
#define TRRD(dst, off) asm volatile("ds_read_b64_tr_b16 %0, %1 offset:%2" : "=&v"(dst) : "v"(vb0), "i"(off) : "memory")
#define PV_D0(d0) do { s16x4 l0, l1, l2, l3, h0, h1, h2, h3; constexpr int b_ = v_rd_off(d0, 0, 0); \
        TRRD(l0, b_); TRRD(h0, b_ + 2048); TRRD(l1, b_ + 4096); TRRD(h1, b_ + 6144); TRRD(l2, b_ + 8192); TRRD(h2, b_ + 10240); TRRD(l3, b_ + 12288); TRRD(h3, b_ + 14336); \
        asm volatile("s_waitcnt lgkmcnt(0)" ::: "memory"); SBAR();   \
        o[d0] = __builtin_amdgcn_mfma_f32_32x32x16_bf16(pa0, (bf16x8){l0[0], l0[1], l0[2], l0[3], h0[0], h0[1], h0[2], h0[3]}, o[d0], 0, 0, 0);   \
        o[d0] = __builtin_amdgcn_mfma_f32_32x32x16_bf16(pa1, (bf16x8){l1[0], l1[1], l1[2], l1[3], h1[0], h1[1], h1[2], h1[3]}, o[d0], 0, 0, 0);   \
        o[d0] = __builtin_amdgcn_mfma_f32_32x32x16_bf16(pa2, (bf16x8){l2[0], l2[1], l2[2], l2[3], h2[0], h2[1], h2[2], h2[3]}, o[d0], 0, 0, 0);   \
        o[d0] = __builtin_amdgcn_mfma_f32_32x32x16_bf16(pa3, (bf16x8){l3[0], l3[1], l3[2], l3[3], h3[0], h3[1], h3[2], h3[3]}, o[d0], 0, 0, 0); } while (0)
    PV_D0(0); PV_D0(1); PV_D0(2); PV_D0(3);
#undef PV_D0
#undef TRRD
}
__device__ __forceinline__ void attn_unit(int b, int h, int qb, const bf16_t* __restrict__ Q, const bf16_t* __restrict__ KVp, const bf16_t* __restrict__ KR, bf16_t* __restrict__ O, char* lds) {
    int tid_o = threadIdx.x; asm volatile("" : "+v"(tid_o)); const int tid = tid_o, wid = __builtin_amdgcn_readfirstlane(tid >> 6), lane = tid & 63, r32 = lane & 31, hi = lane >> 5;
    const size_t rowbase = (size_t)b * SEQ; const int q0 = qb * QB;
    char* V_lds = lds + OFF_V; char* K_lds = lds + OFF_K;
    float* ws = (float*)(lds + OFF_WS) + wid * 64; float* li_l = ws; float* al_l = ws + 32;
    bf16x8 qr[12];
    { const bf16_t* Qw = Q + (rowbase + q0 + wid * QBLK + r32) * NQ + h * DQK + hi * 8;
#pragma unroll
      for (int d0 = 0; d0 < 12; ++d0) qr[d0] = *reinterpret_cast<const bf16x8*>(Qw + d0 * 16); }
    const bf16_t* ksrc[3]; int kstr[3], kdst[3];
#pragma unroll
    for (int i = 0; i < 3; ++i) { const int c = tid + 512 * i, kr = c / 24, kc = c - kr * 24;
        if (kc < 16) { ksrc[i] = KVp + (rowbase + kr) * NKV + h * 256 + kc * 8; kstr[i] = KVBLK * NKV; }
        else { ksrc[i] = KR + (rowbase + kr) * 64 + (kc - 16) * 8; kstr[i] = KVBLK * 64; }
        kdst[i] = kr * KROW + kc * 16; }
    const int sr = tid >> 4, sc = (tid & 15) * 8;
    const bf16_t* vsrc = KVp + (rowbase + sr) * NKV + h * 256 + 128 + sc;
    const int vst0 = v_st(sr, sc), vst1 = v_st(32 + sr, sc);
    const int vb0 = (int)(uintptr_t)V_lds + v_rd_base(lane);
    const int NT = 4 * qb + 4;
    const int qlo = q0 + wid * QBLK, qm = qlo + r32 - 4 * hi;
    bf16x8 sk0, sk1, sk2, sv0, sv1;
#define SLOAD(t) do { sk0 = *reinterpret_cast<const bf16x8*>(ksrc[0] + (size_t)(t) * kstr[0]); sk1 = *reinterpret_cast<const bf16x8*>(ksrc[1] + (size_t)(t) * kstr[1]); \
        sk2 = *reinterpret_cast<const bf16x8*>(ksrc[2] + (size_t)(t) * kstr[2]); \
        sv0 = *reinterpret_cast<const bf16x8*>(vsrc + (size_t)(t) * KVBLK * NKV); sv1 = *reinterpret_cast<const bf16x8*>(vsrc + (size_t)(t) * KVBLK * NKV + 32 * NKV); } while (0)
#define SWRITE(bf) do { *reinterpret_cast<bf16x8*>(K_lds + (bf) * SHM_K + kdst[0]) = sk0; *reinterpret_cast<bf16x8*>(K_lds + (bf) * SHM_K + kdst[1]) = sk1; \
        *reinterpret_cast<bf16x8*>(K_lds + (bf) * SHM_K + kdst[2]) = sk2; \
        *reinterpret_cast<bf16x8*>(V_lds + (bf) * SHM_V + vst0) = sv0; *reinterpret_cast<bf16x8*>(V_lds + (bf) * SHM_V + vst1) = sv1; } while (0)
    SLOAD(0); SWRITE(0); __syncthreads();
    float m_reg = -1e30f, l_reg = 0.f; f32x16 o[4];
#pragma unroll
    for (int d = 0; d < 4; ++d) o[d] = f32x16{};
    for (int t = 0; t < NT; ++t) {
        const int cur = t & 1;
        if (t + 1 < NT) { SLOAD(t + 1); } SBAR();
        f32x16 p0, p1; float mn, alpha; bf16x8 pa0, pa1, pa2, pa3;
        qkt(p0, p1, K_lds + cur * SHM_K, r32, hi, qr);
        const int kb = t * KVBLK;
        if (kb + KVBLK - 1 > qlo) mask_tile(p0, p1, qm - kb);
        partialSM(p0, p1, m_reg, mn, alpha);
        if (__any(alpha < 1.f)) { if (hi == 0) al_l[r32] = alpha; asm volatile("s_waitcnt lgkmcnt(0)" ::: "memory");
#pragma unroll
            for (int d_ = 0; d_ < 4; ++d_)
#pragma unroll
                for (int r = 0; r < 16; ++r) o[d_][r] *= al_l[crow(r, hi)]; }
        finishSM(p0, p1, alpha, l_reg, pa0, pa1, pa2, pa3); SBAR();
        pv_tile(o, vb0 + cur * SHM_V, pa0, pa1, pa2, pa3);
        if (t + 1 < NT) { SWRITE(cur ^ 1); }
        __syncthreads();
    }
    if (hi == 0) li_l[r32] = l_reg; asm volatile("s_waitcnt lgkmcnt(0)" ::: "memory");
    float rli[16];
#pragma unroll
    for (int r = 0; r < 16; ++r) rli[r] = __builtin_amdgcn_rcpf(li_l[crow(r, hi)]);
    bf16_t* Ow = O + (rowbase + q0 + wid * QBLK) * DM + h * DV;
#pragma unroll
    for (int r = 0; r < 16; ++r) { const int orow = crow(r, hi);
#pragma unroll
        for (int d0 = 0; d0 < 4; ++d0) { const float v = o[d0][r] * rli[r]; const float vn = __shfl_xor(v, 1);
            if ((r32 & 1) == 0) *(unsigned*)(Ow + (size_t)orow * DM + d0 * 32 + r32) = cvtpk(v, vn); } }
    __syncthreads();
#undef SLOAD
#undef SWRITE
}
#undef SBAR
}
using pg8::Gemm; using pg8::StaticOrder; using pg8::gemm_phase;
#define LDS_WAIT() asm volatile("s_waitcnt lgkmcnt(0)" ::: "memory")
constexpr int NWAVES = 8, NTHREADS = 512;
constexpr int LDS_BYTES = 135168;

__device__ __forceinline__ float wave_sum(float v) {
#pragma unroll
    for (int o = 1; o < 64; o <<= 1) v += __shfl_xor(v, o);
    return v;
}
__device__ __forceinline__ unsigned pk2(float lo, float hi) { return pg8::cvt_pk_bf16(lo, hi); }
__device__ __forceinline__ float bflo(unsigned u) { return __uint_as_float(u << 16); }
__device__ __forceinline__ float bfhi(unsigned u) { return __uint_as_float(u & 0xffff0000u); }
__device__ __forceinline__ void unpack8(const u32x4 w, float* f) { f[0] = bflo(w.x); f[1] = bfhi(w.x); f[2] = bflo(w.y); f[3] = bfhi(w.y); f[4] = bflo(w.z); f[5] = bfhi(w.z); f[6] = bflo(w.w); f[7] = bfhi(w.w); }
__device__ __forceinline__ u32x4 pack8f(const float* f) { u32x4 w; w.x = pk2(f[0], f[1]); w.y = pk2(f[2], f[3]); w.z = pk2(f[4], f[5]); w.w = pk2(f[6], f[7]); return w; }

template <int MAP> __device__ __forceinline__ int wmap(int n) {
    if (MAP == 1) { return n < 1280 ? n : (n < 1344 ? n + (PC_KR - 1280) : n - 64); }
    if (MAP == 2) { const int h = n / 192, w = n - h * 192; if (w < 128) return n; const int j = w - 128;
                    return h * 192 + 128 + (j < 32 ? 2 * j : 2 * (j - 32) + 1); }
    if (MAP == 3) { if (n < DFF) return (n >> 7) * 256 + (n & 127); const int n2 = n - DFF; return (n2 >> 7) * 256 + 128 + (n2 & 127); }
    return n;
}
template <int MAP> __device__ __forceinline__ void transpose_item(const float* __restrict__ W, int K, int N, bf16_t* __restrict__ WT, LAS float* scr, int item, int lane) {
    const int nblk = N / 32, kb = item / nblk, nb = item - kb * nblk, k0 = 64 * kb, n0 = 32 * nb;
    { const int lr = lane >> 3, lc = (lane & 7) * 4; f32x4 v[8];
#pragma unroll
      for (int i = 0; i < 8; ++i) v[i] = *(const f32x4*)(W + (size_t)(k0 + i * 8 + lr) * N + n0 + lc);
#pragma unroll
      for (int i = 0; i < 8; ++i) { LAS float* sp = scr + (i * 8 + lr) * 33 + lc; sp[0] = v[i][0]; sp[1] = v[i][1]; sp[2] = v[i][2]; sp[3] = v[i][3]; } }
    LDS_WAIT(); asm volatile("" ::: "memory");
    const int c = lane & 7;
#pragma unroll
    for (int j = 0; j < 4; ++j) { const int n = (lane >> 3) + 8 * j; const LAS float* s = scr + (8 * c) * 33 + n;
        u32x4 o; o.x = pk2(s[0 * 33], s[1 * 33]); o.y = pk2(s[2 * 33], s[3 * 33]); o.z = pk2(s[4 * 33], s[5 * 33]); o.w = pk2(s[6 * 33], s[7 * 33]);
        *(u32x4*)(WT + (size_t)wmap<MAP>(n0 + n) * K + k0 + 8 * c) = o; }
    LDS_WAIT(); asm volatile("" ::: "memory");
}

struct Args {
    const float* x; const float* c; const int* pos; const float* w_ada; const float* b_ada; const float* g_pre_mix; const float* g_post_mix;
    const float* w_in; const float* g_q; const float* w_uq; const float* g_kv; const float* w_ukv; const float* conv_w_mix; const float* conv_b_mix;
    const float* w_o; const float* g_pre_ffn; const float* g_post_ffn; const float* w_up; const float* conv_w_ffn; const float* conv_b_ffn; const float* w_down;
    float* out; unsigned char* ws;
};

__device__ __forceinline__ void ph_prologue(const Args& a, LAS unsigned char* lds, int G) {
    int tid_o = threadIdx.x; asm volatile("" : "+v"(tid_o)); const int tid = tid_o, lane = tid & 63, wave = tid >> 6;
    unsigned char* ws = a.ws;
    float* MOD = (float*)(ws + WS_MOD);
    for (int it = blockIdx.x; it < NMODC / 64; it += G) {
        LAS float* red = (LAS float*)lds;
        const int kg = tid >> 4, l16 = tid & 15, col = it * 64 + l16 * 4;
        f32x4 a0 = {0.f, 0.f, 0.f, 0.f}, a1 = {0.f, 0.f, 0.f, 0.f};
#pragma unroll 8
        for (int i = 0; i < 64; ++i) { const int k = kg + 32 * i;
            const f32x4 w = *(const f32x4*)(a.w_ada + (size_t)k * NMODC + col);
            const float c0 = a.c[k], c1 = a.c[DM + k];
            const float s0 = c0 / (1.f + __expf(-c0)), s1 = c1 / (1.f + __expf(-c1));
            a0 += w * s0; a1 += w * s1; }
        LAS float* rp = red + (kg * 16 + l16) * 8;
        rp[0] = a0[0]; rp[1] = a0[1]; rp[2] = a0[2]; rp[3] = a0[3]; rp[4] = a1[0]; rp[5] = a1[1]; rp[6] = a1[2]; rp[7] = a1[3];
        __syncthreads();
        if (tid < 128) { const int b = tid >> 6, cc = tid & 63; float s = 0.f;
            for (int g = 0; g < 32; ++g) s += red[(g * 16 + (cc >> 2)) * 8 + b * 4 + (cc & 3)];
            MOD[b * NMODC + it * 64 + cc] = s + a.b_ada[it * 64 + cc]; }
        __syncthreads();
    }
    LAS float* scr = (LAS float*)(lds + wave * 16384);
    const int gw = blockIdx.x * NWAVES + wave, NGW = G * NWAVES;
    bf16_t* WinT = (bf16_t*)(ws + WS_WIN); bf16_t* WuqT = (bf16_t*)(ws + WS_WUQ); bf16_t* WukvT = (bf16_t*)(ws + WS_WUKV);
    bf16_t* WoT = (bf16_t*)(ws + WS_WO); bf16_t* WupT = (bf16_t*)(ws + WS_WUP); bf16_t* WdnT = (bf16_t*)(ws + WS_WDN);
    constexpr int I_IN = (DM / 64) * (INC / 32), I_UQ = (QL / 64) * (NQ / 32), I_UKV = (KVL / 64) * (NKV / 32), I_O = (DM / 64) * (DM / 32), I_UP = (DM / 64) * (NUP / 32), I_DN = (DFF / 64) * (DM / 32);
    constexpr int NITEMS = I_IN + I_UQ + I_UKV + I_O + I_UP + I_DN;
    for (int it = gw; it < NITEMS; it += NGW) {
        int r = it;
        if (r < I_UP) { transpose_item<3>(a.w_up, DM, NUP, WupT, scr, r, lane); continue; } r -= I_UP;
        if (r < I_DN) { transpose_item<0>(a.w_down, DFF, DM, WdnT, scr, r, lane); continue; } r -= I_DN;
        if (r < I_IN) { transpose_item<1>(a.w_in, DM, INC, WinT, scr, r, lane); continue; } r -= I_IN;
        if (r < I_O) { transpose_item<0>(a.w_o, DM, DM, WoT, scr, r, lane); continue; } r -= I_O;
        if (r < I_UQ) { transpose_item<2>(a.w_uq, QL, NQ, WuqT, scr, r, lane); continue; } r -= I_UQ;
        transpose_item<0>(a.w_ukv, KVL, NKV, WukvT, scr, r, lane);
    }
    const int gt = blockIdx.x * NTHREADS + tid, NGT = G * NTHREADS;
    { u32x4* z = (u32x4*)(WinT + (size_t)INC * DM); const int nz = (INP - INC) * DM / 8;
      for (int i = gt; i < nz; i += NGT) z[i] = (u32x4){0u, 0u, 0u, 0u}; }
    { f32x2* CS = (f32x2*)(ws + WS_CS);
      for (int i = gt; i < M * 32; i += NGT) { const int row = i >> 5, j = i & 31;
          const float inv = 1.0f / exp2f((float)(2 * j) * (13.287712379549449f / 64.f));
          const float ang = (float)a.pos[row] * inv;
          const double rv = (double)ang * 0.15915494309189535; const float f = (float)(rv - __builtin_rint(rv));
          CS[i] = (f32x2){__builtin_amdgcn_cosf(f), __builtin_amdgcn_sinf(f)}; } }
}

__device__ __forceinline__ void ph_prenorm(const float* __restrict__ x, const float* __restrict__ g, const float* __restrict__ mod, int sh_i, int sc_i, bf16_t* __restrict__ XN, int gw, int NGW, int lane) {
    for (int row = gw; row < M; row += NGW) {
        const float* mb = mod + (row >= SEQ ? NMODC : 0);
        const f32x4* xr = (const f32x4*)(x + (size_t)row * DM) + lane;
        f32x4 v[8]; float ss = 0.f;
#pragma unroll
        for (int j = 0; j < 8; ++j) { v[j] = xr[64 * j]; ss += (v[j][0] * v[j][0] + v[j][1] * v[j][1]) + (v[j][2] * v[j][2] + v[j][3] * v[j][3]); }
        const float rstd = rsqrtf(wave_sum(ss) * (1.f / DM) + RMS_EPS);
#pragma unroll
        for (int j = 0; j < 8; ++j) { const int e = (lane + 64 * j) * 4;
            const f32x4 g4 = *(const f32x4*)(g + e), s4 = *(const f32x4*)(mb + sc_i * DM + e), h4 = *(const f32x4*)(mb + sh_i * DM + e);
            const f32x4 o = v[j] * rstd * g4 * (s4 + 1.f) + h4;
            *(u32x2*)(XN + (size_t)row * DM + e) = (u32x2){pk2(o[0], o[1]), pk2(o[2], o[3])}; }
    }
}

__device__ __forceinline__ void ph_mid(const Args& a, int gw, int NGW, int lane) {
    unsigned char* ws = a.ws;
    const bf16_t* PROJ = (const bf16_t*)(ws + WS_PROJ); const float* CS = (const float*)(ws + WS_CS);
    bf16_t* QN = (bf16_t*)(ws + WS_QN); bf16_t* KVN = (bf16_t*)(ws + WS_KVN); bf16_t* KR = (bf16_t*)(ws + WS_KR); bf16_t* MIXIN = (bf16_t*)(ws + WS_XN);
    for (int row = gw; row < M; row += NGW) {
        const bf16_t* pr = PROJ + (size_t)row * INP;
        {
            float f[3][4]; float ss = 0.f;
#pragma unroll
            for (int j = 0; j < 3; ++j) { const u32x2 w = *(const u32x2*)(pr + PC_Q + (lane + 64 * j) * 4);
                f[j][0] = bflo(w.x); f[j][1] = bfhi(w.x); f[j][2] = bflo(w.y); f[j][3] = bfhi(w.y);
                ss += (f[j][0] * f[j][0] + f[j][1] * f[j][1]) + (f[j][2] * f[j][2] + f[j][3] * f[j][3]); }
            const float rstd = rsqrtf(wave_sum(ss) * (1.f / QL) + RMS_EPS);
#pragma unroll
            for (int j = 0; j < 3; ++j) { const int e = (lane + 64 * j) * 4; const f32x4 g4 = *(const f32x4*)(a.g_q + e);
                *(u32x2*)(QN + (size_t)row * QL + e) = (u32x2){pk2(f[j][0] * rstd * g4[0], f[j][1] * rstd * g4[1]), pk2(f[j][2] * rstd * g4[2], f[j][3] * rstd * g4[3])}; }
        }
        {
            float f[8]; unpack8(*(const u32x4*)(pr + PC_KV + lane * 8), f); float ss = 0.f;
#pragma unroll
            for (int i = 0; i < 8; ++i) ss += f[i] * f[i];
            const float rstd = rsqrtf(wave_sum(ss) * (1.f / KVL) + RMS_EPS);
            const f32x4 g0 = *(const f32x4*)(a.g_kv + lane * 8), g1 = *(const f32x4*)(a.g_kv + lane * 8 + 4);
#pragma unroll
            for (int i = 0; i < 4; ++i) { f[i] *= rstd * g0[i]; f[4 + i] *= rstd * g1[i]; }
            *(u32x4*)(KVN + (size_t)row * KVL + lane * 8) = pack8f(f);
        }
        if (lane < 32) {
            const float x1 = __uint_as_float((unsigned)pr[PC_KR + lane] << 16), x2 = __uint_as_float((unsigned)pr[PC_KR + 32 + lane] << 16);
            const f32x2 cs = *(const f32x2*)(CS + (size_t)row * 64 + 2 * lane);
            *(unsigned*)(KR + (size_t)row * 64 + 2 * lane) = pk2(x1 * cs.x - x2 * cs.y, x2 * cs.x + x1 * cs.y);
        }
        const int tt = row & (SEQ - 1);
#pragma unroll
        for (int j = 0; j < 2; ++j) {
            const int c0 = lane * 8 + 512 * j;
            float gb[8], p0[8], p1[8], p2[8], t0[8], t1[8];
            unpack8(*(const u32x4*)(pr + PC_GB + c0), gb);
            unpack8(*(const u32x4*)(pr + PC_GC + c0), t0); unpack8(*(const u32x4*)(pr + PC_CI + c0), t1);
#pragma unroll
            for (int i = 0; i < 8; ++i) p0[i] = t0[i] * t1[i];
            if (tt >= 1) { unpack8(*(const u32x4*)(pr - INP + PC_GC + c0), t0); unpack8(*(const u32x4*)(pr - INP + PC_CI + c0), t1); }
#pragma unroll
            for (int i = 0; i < 8; ++i) p1[i] = tt >= 1 ? t0[i] * t1[i] : 0.f;
            if (tt >= 2) { unpack8(*(const u32x4*)(pr - 2 * INP + PC_GC + c0), t0); unpack8(*(const u32x4*)(pr - 2 * INP + PC_CI + c0), t1); }
#pragma unroll
            for (int i = 0; i < 8; ++i) p2[i] = tt >= 2 ? t0[i] * t1[i] : 0.f;
            float o[8];
#pragma unroll
            for (int i = 0; i < 8; ++i) { const float w0 = a.conv_w_mix[c0 + i], w1 = a.conv_w_mix[CW + c0 + i], w2 = a.conv_w_mix[2 * CW + c0 + i], bb = a.conv_b_mix[c0 + i];
                o[i] = gb[i] * (w0 * p2[i] + w1 * p1[i] + w2 * p0[i] + bb); }
            *(u32x4*)(MIXIN + (size_t)row * DM + CW + c0) = pack8f(o);
        }
    }
}

__device__ __forceinline__ void ph_post_mix(const Args& a, int gw, int NGW, int lane) {
    unsigned char* ws = a.ws; const bf16_t* MIX = (const bf16_t*)(ws + WS_PROJ); const float* mod = (const float*)(ws + WS_MOD); bf16_t* XN2 = (bf16_t*)(ws + WS_XN);
    for (int row = gw; row < M; row += NGW) {
        const float* mb = mod + (row >= SEQ ? NMODC : 0);
        const f32x4* xr = (const f32x4*)(a.x + (size_t)row * DM) + 2 * lane;
        f32x4 v[8], xv[8]; float ss = 0.f;
#pragma unroll
        for (int j = 0; j < 4; ++j) { const u32x4 w = *(const u32x4*)(MIX + (size_t)row * DM + (lane + 64 * j) * 8); xv[2 * j] = xr[128 * j]; xv[2 * j + 1] = xr[128 * j + 1];
            v[2 * j] = (f32x4){bflo(w.x), bfhi(w.x), bflo(w.y), bfhi(w.y)}; v[2 * j + 1] = (f32x4){bflo(w.z), bfhi(w.z), bflo(w.w), bfhi(w.w)}; }
#pragma unroll
        for (int j = 0; j < 8; ++j) ss += (v[j][0] * v[j][0] + v[j][1] * v[j][1]) + (v[j][2] * v[j][2] + v[j][3] * v[j][3]);
        const float rstd = rsqrtf(wave_sum(ss) * (1.f / DM) + RMS_EPS);
        float ss2 = 0.f;
#pragma unroll
        for (int j = 0; j < 8; ++j) { const int e = (lane + 64 * (j >> 1)) * 8 + (j & 1) * 4;
            const f32x4 g4 = *(const f32x4*)(a.g_post_mix + e), gt = *(const f32x4*)(mb + 2 * DM + e);
            const f32x4 x1 = xv[j] + gt * (v[j] * rstd * g4);
            *(f32x4*)(a.out + (size_t)row * DM + e) = x1; v[j] = x1;
            ss2 += (x1[0] * x1[0] + x1[1] * x1[1]) + (x1[2] * x1[2] + x1[3] * x1[3]); }
        const float rstd2 = rsqrtf(wave_sum(ss2) * (1.f / DM) + RMS_EPS);
#pragma unroll
        for (int j = 0; j < 4; ++j) { const int e = (lane + 64 * j) * 8; f32x4 o[2];
#pragma unroll
            for (int hh = 0; hh < 2; ++hh) { const f32x4 g4 = *(const f32x4*)(a.g_pre_ffn + e + 4 * hh), s4 = *(const f32x4*)(mb + 4 * DM + e + 4 * hh), h4 = *(const f32x4*)(mb + 3 * DM + e + 4 * hh);
                o[hh] = v[2 * j + hh] * rstd2 * g4 * (s4 + 1.f) + h4; }
            *(u32x4*)(XN2 + (size_t)row * DM + e) = (u32x4){pk2(o[0][0], o[0][1]), pk2(o[0][2], o[0][3]), pk2(o[1][0], o[1][1]), pk2(o[1][2], o[1][3])}; }
    }
}

__device__ __forceinline__ void ph_act(const Args& a, int t0, int ntiles, int gt, int NGT) {
    unsigned char* ws = a.ws; const bf16_t* U = (const bf16_t*)(ws + WS_U); bf16_t* ACT = (bf16_t*)(ws + WS_ACT);
    const int Np = ntiles * 256, nch = ntiles * 16, total = (M / 8) * nch;
    for (int idx = gt; idx < total; idx += NGT) {
        const int rb = idx / nch, ch = idx - rb * nch, tile = ch >> 4, cc = ch & 15;
        const int ucol = tile * 256 + cc * 8, acol = (t0 + tile) * 128 + cc * 8;
        float wa[3][8], wg[3][8], ba[8], bg[8];
#pragma unroll
        for (int k = 0; k < 3; ++k) {
            const f32x4 q0 = *(const f32x4*)(a.conv_w_ffn + k * NUP + acol), q1 = *(const f32x4*)(a.conv_w_ffn + k * NUP + acol + 4);
            const f32x4 r0 = *(const f32x4*)(a.conv_w_ffn + k * NUP + DFF + acol), r1 = *(const f32x4*)(a.conv_w_ffn + k * NUP + DFF + acol + 4);
#pragma unroll
            for (int i = 0; i < 4; ++i) { wa[k][i] = q0[i]; wa[k][4 + i] = q1[i]; wg[k][i] = r0[i]; wg[k][4 + i] = r1[i]; } }
        { const f32x4 q0 = *(const f32x4*)(a.conv_b_ffn + acol), q1 = *(const f32x4*)(a.conv_b_ffn + acol + 4);
          const f32x4 r0 = *(const f32x4*)(a.conv_b_ffn + DFF + acol), r1 = *(const f32x4*)(a.conv_b_ffn + DFF + acol + 4);
#pragma unroll
          for (int i = 0; i < 4; ++i) { ba[i] = q0[i]; ba[4 + i] = q1[i]; bg[i] = r0[i]; bg[4 + i] = r1[i]; } }
        const int r0w = rb * 8; const bool first = (r0w & (SEQ - 1)) == 0;
        float a1[8], a2[8], g1[8], g2[8];
#pragma unroll
        for (int i = 0; i < 8; ++i) { a1[i] = 0.f; a2[i] = 0.f; g1[i] = 0.f; g2[i] = 0.f; }
        if (!first) { const bf16_t* up = U + (size_t)(r0w - 2) * Np + ucol;
            unpack8(*(const u32x4*)up, a2); unpack8(*(const u32x4*)(up + 128), g2); unpack8(*(const u32x4*)(up + Np), a1); unpack8(*(const u32x4*)(up + Np + 128), g1); }
#pragma unroll
        for (int r = 0; r < 8; ++r) { const bf16_t* up = U + (size_t)(r0w + r) * Np + ucol;
            float a0[8], g0[8], o[8]; unpack8(*(const u32x4*)up, a0); unpack8(*(const u32x4*)(up + 128), g0);
#pragma unroll
            for (int i = 0; i < 8; ++i) { const float ua = wa[0][i] * a2[i] + wa[1][i] * a1[i] + wa[2][i] * a0[i] + ba[i];
                const float ug = wg[0][i] * g2[i] + wg[1][i] * g1[i] + wg[2][i] * g0[i] + bg[i];
                o[i] = ua * ug * __builtin_amdgcn_rcpf(1.f + __expf(-ug)); a2[i] = a1[i]; a1[i] = a0[i]; g2[i] = g1[i]; g1[i] = g0[i]; }
            *(u32x4*)(ACT + (size_t)(r0w + r) * DFF + acol) = pack8f(o); }
    }
}

__device__ __forceinline__ void ph_final(const Args& a, int gw, int NGW, int lane) {
    unsigned char* ws = a.ws; const bf16_t* Y = (const bf16_t*)(ws + WS_Y); const float* mod = (const float*)(ws + WS_MOD);
    for (int row = gw; row < M; row += NGW) {
        const float* mb = mod + (row >= SEQ ? NMODC : 0);
        const f32x4* xr = (const f32x4*)(a.out + (size_t)row * DM) + 2 * lane;
        f32x4 v[8], xv[8]; float ss = 0.f;
#pragma unroll
        for (int j = 0; j < 4; ++j) { const u32x4 w = *(const u32x4*)(Y + (size_t)row * DM + (lane + 64 * j) * 8); xv[2 * j] = xr[128 * j]; xv[2 * j + 1] = xr[128 * j + 1];
            v[2 * j] = (f32x4){bflo(w.x), bfhi(w.x), bflo(w.y), bfhi(w.y)}; v[2 * j + 1] = (f32x4){bflo(w.z), bfhi(w.z), bflo(w.w), bfhi(w.w)}; }
#pragma unroll
        for (int j = 0; j < 8; ++j) ss += (v[j][0] * v[j][0] + v[j][1] * v[j][1]) + (v[j][2] * v[j][2] + v[j][3] * v[j][3]);
        const float rstd = rsqrtf(wave_sum(ss) * (1.f / DM) + RMS_EPS);
#pragma unroll
        for (int j = 0; j < 8; ++j) { const int e = (lane + 64 * (j >> 1)) * 8 + (j & 1) * 4;
            const f32x4 g4 = *(const f32x4*)(a.g_post_ffn + e), gt = *(const f32x4*)(mb + 5 * DM + e);
            *(f32x4*)(a.out + (size_t)row * DM + e) = xv[j] + gt * (v[j] * rstd * g4); }
    }
}

#ifndef PROBE_THIN
#define PROBE_THIN 1
#endif
#ifndef PROBE_ATT
#define PROBE_ATT 1
#endif
__global__ void __launch_bounds__(NTHREADS, 2) mega_fwd(Args a) {
    extern __shared__ __attribute__((aligned(16))) unsigned char lds_raw[];
    cg::grid_group grid = cg::this_grid();
    LAS unsigned char* lds = (LAS unsigned char*)lds_raw;
    const int tid = threadIdx.x, lane = tid & 63, wave = __builtin_amdgcn_readfirstlane(tid >> 6);
    const int G = gridDim.x, bid = blockIdx.x;
    const int gw = bid * NWAVES + wave, NGW = G * NWAVES, gt = bid * NTHREADS + tid, NGT = G * NTHREADS;
    unsigned char* ws = a.ws;
    bf16_t* XN = (bf16_t*)(ws + WS_XN);

    ph_prologue(a, lds, G);
    grid.sync();
    for (int rep = 0; rep < PROBE_THIN; ++rep) ph_prenorm(a.x, a.g_pre_mix, (const float*)(ws + WS_MOD), 0, 1, XN, gw, NGW, lane);
    grid.sync();
    {
        Gemm g{XN, (const bf16_t*)(ws + WS_WIN), M, INP, DM}; StaticOrder S; S.init(M, INP, G, bid);
        pg8::EpiBf16 E{(bf16_t*)(ws + WS_PROJ), INP};
        gemm_phase<pg8::EpiBf16, StaticOrder, true, true>(lds, g, S, E);
    }
    grid.sync();
    for (int rep = 0; rep < PROBE_THIN; ++rep) ph_mid(a, gw, NGW, lane);
    grid.sync();
    {
        Gemm g{(const bf16_t*)(ws + WS_QN), (const bf16_t*)(ws + WS_WUQ), M, NQ, QL}; StaticOrder S; S.init(M, NQ, G, bid);
        pg8::EpiQ E{(bf16_t*)(ws + WS_Q), (const float*)(ws + WS_CS)};
        gemm_phase<pg8::EpiQ, StaticOrder, true, true>(lds, g, S, E);
        Gemm g2{(const bf16_t*)(ws + WS_KVN), (const bf16_t*)(ws + WS_WUKV), M, NKV, KVL}; StaticOrder S2; S2.init(M, NKV, G, bid);
        pg8::EpiBf16 E2{(bf16_t*)(ws + WS_KV), NKV};
        gemm_phase<pg8::EpiBf16, StaticOrder, true, true>(lds, g2, S2, E2);
    }
    grid.sync();
    {
        for (int rep = 0; rep < PROBE_ATT; ++rep)
        for (int L = bid; L < 256; L += G) {
            const int v = (L & 7) * 32 + (L >> 3), bh = v >> 4, s = v & 15;
            att::attn_unit(bh >> 3, bh & 7, 31 - s, (const bf16_t*)(ws + WS_Q), (const bf16_t*)(ws + WS_KV), (const bf16_t*)(ws + WS_KR), XN, (char*)lds_raw);
            att::attn_unit(bh >> 3, bh & 7, s, (const bf16_t*)(ws + WS_Q), (const bf16_t*)(ws + WS_KV), (const bf16_t*)(ws + WS_KR), XN, (char*)lds_raw);
        }
    }
    grid.sync();
    {
        Gemm g{XN, (const bf16_t*)(ws + WS_WO), M, DM, DM}; StaticOrder S; S.init(M, DM, G, bid);
        pg8::EpiBf16 E{(bf16_t*)(ws + WS_PROJ), DM};
        gemm_phase<pg8::EpiBf16, StaticOrder, true, true>(lds, g, S, E);
    }
    grid.sync();
    for (int rep = 0; rep < PROBE_THIN; ++rep) ph_post_mix(a, gw, NGW, lane);
    grid.sync();
    {
        Gemm g{XN, (const bf16_t*)(ws + WS_WUP), M, UP_TA * 256, DM}; StaticOrder S; S.init(M, UP_TA * 256, G, bid);
        pg8::EpiBf16 E{(bf16_t*)(ws + WS_U), UP_TA * 256};
        gemm_phase<pg8::EpiBf16, StaticOrder, true, true>(lds, g, S, E);
    }
    grid.sync();
    for (int rep = 0; rep < PROBE_THIN; ++rep) ph_act(a, 0, UP_TA, gt, NGT);
    grid.sync();
    {
        Gemm g{XN, (const bf16_t*)(ws + WS_WUP) + (size_t)UP_TA * 256 * DM, M, UP_TB * 256, DM}; StaticOrder S; S.init(M, UP_TB * 256, G, bid);
        pg8::EpiBf16 E{(bf16_t*)(ws + WS_U), UP_TB * 256};
        gemm_phase<pg8::EpiBf16, StaticOrder, true, true>(lds, g, S, E);
    }
    grid.sync();
    for (int rep = 0; rep < PROBE_THIN; ++rep) ph_act(a, UP_TA, UP_TB, gt, NGT);
    grid.sync();
    {
        Gemm g{(const bf16_t*)(ws + WS_ACT), (const bf16_t*)(ws + WS_WDN), M, DM, DFF}; StaticOrder S; S.init(M, DM, G, bid);
        pg8::EpiBf16 E{(bf16_t*)(ws + WS_Y), DM};
        gemm_phase<pg8::EpiBf16, StaticOrder, true, true>(lds, g, S, E);
    }
    grid.sync();
    ph_final(a, gw, NGW, lane);
}

extern "C" void kernel_launch(void* const* d_in, const int* in_sizes, int n_in, void* d_out, int out_size, void* d_ws, size_t ws_size, hipStream_t stream) {
    static int grid = 0;
    if (grid == 0) {
        if (n_in != 21 || in_sizes[0] != M * DM || out_size != M * DM || ws_size < WS_END) {
            fprintf(stderr, "kernel_launch: unexpected shapes (n_in %d, in0 %d, out %d, ws %zu; need ws >= %zu)\n", n_in, n_in > 0 ? in_sizes[0] : -1, out_size, ws_size, (size_t)WS_END); grid = -1; return; }
        int dev = 0, cus = 0, per_cu = 0;
        (void)hipGetDevice(&dev);
        (void)hipDeviceGetAttribute(&cus, hipDeviceAttributeMultiprocessorCount, dev);
        if (hipFuncSetAttribute((const void*)mega_fwd, hipFuncAttributeMaxDynamicSharedMemorySize, LDS_BYTES) != hipSuccess) { fprintf(stderr, "kernel_launch: hipFuncSetAttribute failed\n"); grid = -1; return; }
        if (hipOccupancyMaxActiveBlocksPerMultiprocessor(&per_cu, (const void*)mega_fwd, NTHREADS, LDS_BYTES) != hipSuccess || per_cu < 1) { fprintf(stderr, "kernel_launch: occupancy query failed (%d)\n", per_cu); (void)hipGetLastError(); per_cu = 1; }
        grid = cus * per_cu;
        fprintf(stderr, "kernel_launch: %d CUs x %d workgroups\n", cus, per_cu);
    }
    if (grid < 0) return;
    Args a{};
    a.x = (const float*)d_in[0]; a.c = (const float*)d_in[1]; a.pos = (const int*)d_in[2]; a.w_ada = (const float*)d_in[3]; a.b_ada = (const float*)d_in[4];
    a.g_pre_mix = (const float*)d_in[5]; a.g_post_mix = (const float*)d_in[6]; a.w_in = (const float*)d_in[7]; a.g_q = (const float*)d_in[8]; a.w_uq = (const float*)d_in[9];
    a.g_kv = (const float*)d_in[10]; a.w_ukv = (const float*)d_in[11]; a.conv_w_mix = (const float*)d_in[12]; a.conv_b_mix = (const float*)d_in[13]; a.w_o = (const float*)d_in[14];
    a.g_pre_ffn = (const float*)d_in[15]; a.g_post_ffn = (const float*)d_in[16]; a.w_up = (const float*)d_in[17]; a.conv_w_ffn = (const float*)d_in[18]; a.conv_b_ffn = (const float*)d_in[19];
    a.w_down = (const float*)d_in[20]; a.out = (float*)d_out; a.ws = (unsigned char*)d_ws;
    void* args[] = {&a};
    hipError_t e = hipLaunchCooperativeKernel((const void*)mega_fwd, dim3(grid), dim3(NTHREADS), args, LDS_BYTES, stream);
    if (e != hipSuccess) fprintf(stderr, "kernel_launch: cooperative launch failed: %s (grid %d)\n", hipGetErrorString(e), grid);
}
```

```cpp
#include <hip/hip_runtime.h>
#include <hip/hip_cooperative_groups.h>
#include <cstdio>
#include <cstdint>
namespace cg = cooperative_groups;

constexpr int BATCH = 2, SEQ = 8192, DM = 2048, M = BATCH * SEQ;
constexpr int QL = 768, KVL = 512, ROPE = 64, CW = 1024, INC = 4416, INP = 4608;
constexpr int NH = 8, DQK = 192, NQ = NH * DQK  , NKV = NH * 256  ;
constexpr int DFF = 5632, NUP = 2 * DFF;
constexpr int NMODC = 6 * DM;
constexpr float RMS_EPS = 1e-6f;
constexpr int PC_Q = 0, PC_KV = 768, PC_GB = 1280, PC_GC = 2304, PC_CI = 3328, PC_KR = 4352;
constexpr int UP_TA = 20, UP_TB = 24;

constexpr size_t MiB = 1u << 20;
constexpr size_t WS_WUP = 0, WS_WDN = 44 * MiB, WS_MOD = 66 * MiB;
constexpr size_t WS_XN = 68 * MiB;
constexpr size_t WS_WIN = 132 * MiB, WS_WUQ = 150 * MiB, WS_WUKV = 153 * MiB, WS_WO = 155 * MiB, WS_CS = 163 * MiB;
constexpr size_t WS_PROJ = 168 * MiB;
constexpr size_t WS_QN = 312 * MiB, WS_KVN = 336 * MiB, WS_KR = 352 * MiB, WS_Q = 354 * MiB, WS_KV = 402 * MiB;
constexpr size_t WS_U = 132 * MiB;
constexpr size_t WS_ACT = 324 * MiB;
constexpr size_t WS_Y = 132 * MiB;
constexpr size_t WS_END = 500 * MiB;

#define LAS __attribute__((address_space(3)))
typedef unsigned u32x4 __attribute__((ext_vector_type(4)));
typedef unsigned u32x2 __attribute__((ext_vector_type(2)));
typedef float f32x2 __attribute__((ext_vector_type(2)));
typedef unsigned short bf16_t;
typedef short bf16x8 __attribute__((ext_vector_type(8)));
typedef short s16x4 __attribute__((ext_vector_type(4)));
typedef float f32x4 __attribute__((ext_vector_type(4)));
typedef float f32x16 __attribute__((ext_vector_type(16)));
namespace pg8 {
#define PG8_LAS __attribute__((address_space(3)))
typedef unsigned short bf16_t;
typedef short bf16x8 __attribute__((ext_vector_type(8)));
typedef float f32x4 __attribute__((ext_vector_type(4)));
typedef unsigned u32x4 __attribute__((ext_vector_type(4)));
constexpr int BM = 256, BK = 64, HALF = 128, HTB = HALF * BK * 2  , STAGE_BYTES = 8 * HTB, NXCD = 8, WGM = 8;

__host__ __device__ __forceinline__ int lds_byte(int r, int c) { const int st = (r >> 4) * 2 + (c >> 5), rr = r & 15, cc = c & 31, ob = rr * 64 + cc * 2; return st * 1024 + (ob ^ (((ob >> 9) & 1) << 5)); }
__host__ __device__ __forceinline__ void stage_rc(int b, int& R, int& C) { const int st = b / 1024, sb = b % 1024, swz = sb ^ (((sb >> 9) & 1) << 5); R = (st >> 1) * 16 + swz / 64; C = (st & 1) * 32 + (swz % 64) / 2; }
__host__ __device__ __forceinline__ int perm32(int rho) { const int n = rho >> 4, i = rho & 15; return 8 * (i >> 2) + 4 * n + (i & 3); }

struct Unit { int pm, pn; };
struct Gemm { const bf16_t* A; const bf16_t* Bt; int M, N, K; };

struct StaticOrder {
    int nM, nN, nwg, G, c;
    __host__ __device__ void init(int M, int N, int G_, int c_) { nM = M / BM; nN = N / BM; nwg = nM * nN; G = G_; c = c_; }
    __host__ __device__ bool next(int i, Unit& u) const {
        const long L = (long)i * G + c; if (L >= nwg) return false;
        int wgid = (int)L; { const int q = nwg / NXCD, r = nwg % NXCD, xcd = wgid % NXCD, off = wgid / NXCD; wgid = (xcd < r ? xcd * (q + 1) : r * (q + 1) + (xcd - r) * q) + off; }
        const int nig = WGM * nN, gid = wgid / nig, fm = gid * WGM, gsz = (nM - fm) < WGM ? (nM - fm) : WGM;
        u.pm = fm + ((wgid % nig) % gsz); u.pn = (wgid % nig) / gsz; return true;
    }
    __device__ __forceinline__ void a_ready(const Unit&) const {}
    __device__ __forceinline__ void done(const Unit&) const {}
};

__device__ __forceinline__ unsigned cvt_pk_bf16(float lo, float hi) { unsigned r; asm volatile("v_cvt_pk_bf16_f32 %0, %1, %2" : "=v"(r) : "v"(lo), "v"(hi)); return r; }
struct EpiBf16 {
    static constexpr bool PERM = true, AFTER_DRAIN = false;
    bf16_t* O; int ldc;
    __device__ __forceinline__ void operator()(const f32x4 (&acc)[2][2][4][2], const Unit& u, int wr, int wc, int fr, int fq) const {
        const int row0 = u.pm * BM + wr * 64 + fr, col0 = u.pn * BM + wc * 32 + 8 * fq;
#pragma unroll
        for (int ai = 0; ai < 2; ++ai)
#pragma unroll
            for (int m = 0; m < 4; ++m) { bf16_t* rowp = O + (size_t)(row0 + ai * HALF + m * 16) * ldc + col0;
#pragma unroll
                for (int bj = 0; bj < 2; ++bj) { const f32x4 v0 = acc[ai][bj][m][0], v1 = acc[ai][bj][m][1];
                    u32x4 w; w.x = cvt_pk_bf16(v0[0], v0[1]); w.y = cvt_pk_bf16(v0[2], v0[3]); w.z = cvt_pk_bf16(v1[0], v1[1]); w.w = cvt_pk_bf16(v1[2], v1[3]);
                    *(u32x4*)(rowp + bj * HALF) = w; } }
    }
};
struct EpiF32 {
    static constexpr bool PERM = true, AFTER_DRAIN = false;
    float* O; int ldc;
    __device__ __forceinline__ void operator()(const f32x4 (&acc)[2][2][4][2], const Unit& u, int wr, int wc, int fr, int fq) const {
        const int row0 = u.pm * BM + wr * 64 + fr, col0 = u.pn * BM + wc * 32 + 8 * fq;
#pragma unroll
        for (int ai = 0; ai < 2; ++ai)
#pragma unroll
            for (int m = 0; m < 4; ++m) { float* rowp = O + (size_t)(row0 + ai * HALF + m * 16) * ldc + col0;
#pragma unroll
                for (int bj = 0; bj < 2; ++bj) { *(f32x4*)(rowp + bj * HALF) = acc[ai][bj][m][0]; *(f32x4*)(rowp + bj * HALF + 4) = acc[ai][bj][m][1]; } }
    }
};
struct EpiQ {
    static constexpr bool PERM = true, AFTER_DRAIN = false;
    bf16_t* O; const float* CS;
    __device__ __forceinline__ void operator()(const f32x4 (&acc)[2][2][4][2], const Unit& u, int wr, int wc, int fr, int fq) const {
        const int row0 = u.pm * BM + wr * 64 + fr;
#pragma unroll
        for (int bj = 0; bj < 2; ++bj) {
            const int cb = u.pn * BM + bj * HALF + wc * 32, within = cb % 192; const bool rope = within >= 128;
            const int j0 = ((within - 128) >> 1) + 4 * fq;
#pragma unroll
            for (int ai = 0; ai < 2; ++ai)
#pragma unroll
                for (int m = 0; m < 4; ++m) { const int row = row0 + ai * HALF + m * 16;
                    f32x4 v0 = acc[ai][bj][m][0], v1 = acc[ai][bj][m][1];
                    if (rope) { const f32x4 c0 = *(const f32x4*)(CS + (size_t)row * 64 + j0 * 2), c1 = *(const f32x4*)(CS + (size_t)row * 64 + j0 * 2 + 4);
                        f32x4 a, b;
                        a[0] = v0[0] * c0[0] - v0[1] * c0[1]; a[1] = v0[1] * c0[0] + v0[0] * c0[1]; a[2] = v0[2] * c0[2] - v0[3] * c0[3]; a[3] = v0[3] * c0[2] + v0[2] * c0[3];
                        b[0] = v1[0] * c1[0] - v1[1] * c1[1]; b[1] = v1[1] * c1[0] + v1[0] * c1[1]; b[2] = v1[2] * c1[2] - v1[3] * c1[3]; b[3] = v1[3] * c1[2] + v1[2] * c1[3];
                        v0 = a; v1 = b; }
                    u32x4 w; w.x = cvt_pk_bf16(v0[0], v0[1]); w.y = cvt_pk_bf16(v0[2], v0[3]); w.z = cvt_pk_bf16(v1[0], v1[1]); w.w = cvt_pk_bf16(v1[2], v1[3]);
                    *(u32x4*)(O + (size_t)row * NQ + cb + 8 * fq) = w; }
        }
    }
};
template <class Epi, class Sched, bool ALIGN_EPI = false, bool SP2 = false>
__device__ __forceinline__ void gemm_phase(PG8_LAS unsigned char* lds, const Gemm g, const Sched& S, const Epi& E) {
    int tid_o = threadIdx.x; asm volatile("" : "+v"(tid_o)); const int tid = tid_o, wid = __builtin_amdgcn_readfirstlane(tid >> 6), lane = tid & 63, wr = wid >> 2, wc = wid & 3, fr = lane & 15, fq = lane >> 4;
    const int K = g.K, nt = K / BK;
    unsigned voffA[2], voffB[2];
#pragma unroll
    for (int i = 0; i < 2; ++i) { int R, C; stage_rc(tid * 16 + i * 8192, R, C); const int Rb = Epi::PERM ? ((R & ~31) + perm32(R & 31)) : R;
        voffA[i] = (unsigned)(R * K + C) * 2u; voffB[i] = (unsigned)(Rb * K + C) * 2u; }
    const size_t kstep = (size_t)(BK * 2);
    const size_t hstep = (size_t)HALF * K * 2;
    const size_t tstep = 2 * hstep;
    const unsigned ldsw = (unsigned)wid * 1024u;
    const int aoff = lds_byte(wr * 64 + fr, fq * 8), boff = lds_byte(wc * 32 + fr, fq * 8);
#define PG8_SA(b, h) (((b) * 2 + (h)) * HTB)
#define PG8_SB(b, h) ((4 + (b) * 2 + (h)) * HTB)
#define PG8_STAGE(bufoff, gbase, voff) do { _Pragma("unroll") for (int _i = 0; _i < 2; ++_i) \
        __builtin_amdgcn_global_load_lds((const unsigned*)((const char*)(gbase) + (voff)[_i]), (PG8_LAS unsigned*)(lds + (bufoff) + ldsw + _i * 8192), 16, 0, 0); } while (0)
#define PG8_LDA(dst, b, h) do { _Pragma("unroll") for (int m = 0; m < 4; ++m) _Pragma("unroll") for (int k = 0; k < 2; ++k) dst[m][k] = *(const PG8_LAS bf16x8*)(lds + PG8_SA(b, h) + aoff + m * 2048 + k * 1024); } while (0)
#define PG8_LDB(dst, b, h) do { _Pragma("unroll") for (int n = 0; n < 2; ++n) _Pragma("unroll") for (int k = 0; k < 2; ++k) dst[n][k] = *(const PG8_LAS bf16x8*)(lds + PG8_SB(b, h) + boff + n * 2048 + k * 1024); } while (0)
#define PG8_MMA(ai, bj, At, Bt) do { __builtin_amdgcn_s_setprio(1); _Pragma("unroll") for (int m = 0; m < 4; ++m) _Pragma("unroll") for (int n = 0; n < 2; ++n) _Pragma("unroll") for (int k = 0; k < 2; ++k) \
        acc[ai][bj][m][n] = __builtin_amdgcn_mfma_f32_16x16x32_bf16(Bt[n][k], At[m][k], acc[ai][bj][m][n], 0, 0, 0); __builtin_amdgcn_s_setprio(0); } while (0)
#define PG8_WAIT_V(n) asm volatile("s_waitcnt vmcnt(" #n ")" ::: "memory")
#define PG8_WAIT_L(n) asm volatile("s_waitcnt lgkmcnt(" #n ")" ::: "memory")
#define PG8_BAR __builtin_amdgcn_s_barrier()
#define PG8_SCHED __builtin_amdgcn_sched_barrier(0)
    Unit cur, nxt; int ui = 0;
    if (!S.next(0, cur)) return;
    f32x4 acc[2][2][4][2];
#pragma unroll
    for (int a = 0; a < 2; ++a)
#pragma unroll
        for (int b = 0; b < 2; ++b)
#pragma unroll
            for (int m = 0; m < 4; ++m)
#pragma unroll
                for (int n = 0; n < 2; ++n) acc[a][b][m][n] = (f32x4){0.f, 0.f, 0.f, 0.f};
    bf16x8 At[4][2], B0[2][2], B1[2][2];
    const char* cA = (const char*)g.A + (size_t)cur.pm * tstep; const char* cB = (const char*)g.Bt + (size_t)cur.pn * tstep;
    S.a_ready(cur);
    if constexpr (SP2) {
        PG8_STAGE(PG8_SB(0, 0), cB, voffB); PG8_STAGE(PG8_SB(0, 1), cB + hstep, voffB); PG8_STAGE(PG8_SA(0, 0), cA, voffA); PG8_STAGE(PG8_SA(0, 1), cA + hstep, voffA);
        if (wr == 1) PG8_BAR;
        PG8_WAIT_V(2); PG8_BAR;
        PG8_STAGE(PG8_SB(1, 0), cB + kstep, voffB); PG8_STAGE(PG8_SA(1, 0), cA + kstep, voffA); PG8_STAGE(PG8_SB(1, 1), cB + hstep + kstep, voffB);
        PG8_WAIT_V(6); PG8_BAR;
    } else {
        PG8_STAGE(PG8_SB(0, 0), cB, voffB); PG8_STAGE(PG8_SA(0, 0), cA, voffA); PG8_STAGE(PG8_SB(0, 1), cB + hstep, voffB); PG8_STAGE(PG8_SA(0, 1), cA + hstep, voffA);
        if (wr == 1) PG8_BAR;
        PG8_WAIT_V(4); PG8_BAR;
        PG8_STAGE(PG8_SB(1, 0), cB + kstep, voffB); PG8_STAGE(PG8_SA(1, 0), cA + kstep, voffA); PG8_STAGE(PG8_SB(1, 1), cB + hstep + kstep, voffB);
        PG8_WAIT_V(6); PG8_BAR;
    }
    for (;;) {
        const bool has_next = S.next(ui + 1, nxt);
        const char* nA = has_next ? (const char*)g.A + (size_t)nxt.pm * tstep : cA; const char* nB = has_next ? (const char*)g.Bt + (size_t)nxt.pn * tstep : cB;
        for (int t = 0; t < nt; t += 2) {
            const bool last = (t == nt - 2);
            const char* a1 = cA + (size_t)(t + 1) * kstep;
            const char* a2 = last ? nA : cA + (size_t)(t + 2) * kstep; const char* b2 = last ? nB : cB + (size_t)(t + 2) * kstep;
            const char* a3 = a2 + kstep; const char* b3 = b2 + kstep;
            if (last && has_next) S.a_ready(nxt);
            if constexpr (SP2) {
            PG8_LDB(B0, 0, 0); PG8_LDB(B1, 0, 1); PG8_SCHED; PG8_LDA(At, 0, 0); PG8_STAGE(PG8_SA(1, 1), a1 + hstep, voffA);
            PG8_WAIT_V(8); PG8_WAIT_L(0); PG8_BAR; PG8_MMA(0, 0, At, B0); PG8_MMA(0, 1, At, B1); PG8_BAR; PG8_SCHED;
            PG8_LDA(At, 0, 1); PG8_STAGE(PG8_SB(0, 0), b2, voffB); PG8_STAGE(PG8_SB(0, 1), b2 + hstep, voffB); PG8_STAGE(PG8_SA(0, 0), a2, voffA);
            PG8_WAIT_V(8); PG8_WAIT_L(0); PG8_BAR; PG8_MMA(1, 0, At, B0); PG8_MMA(1, 1, At, B1); PG8_BAR; PG8_SCHED;
            PG8_LDB(B0, 1, 0); PG8_LDB(B1, 1, 1); PG8_SCHED; PG8_LDA(At, 1, 0); PG8_STAGE(PG8_SA(0, 1), a2 + hstep, voffA);
            PG8_WAIT_V(8); PG8_WAIT_L(0); PG8_BAR; PG8_MMA(0, 0, At, B0); PG8_MMA(0, 1, At, B1); PG8_BAR; PG8_SCHED;
            PG8_LDA(At, 1, 1); PG8_STAGE(PG8_SB(1, 0), b3, voffB); PG8_STAGE(PG8_SB(1, 1), b3 + hstep, voffB); PG8_STAGE(PG8_SA(1, 0), a3, voffA);
            PG8_WAIT_V(8); PG8_WAIT_L(0); PG8_BAR; PG8_MMA(1, 0, At, B0); PG8_MMA(1, 1, At, B1); PG8_BAR; PG8_SCHED;
            } else {
            PG8_LDB(B0, 0, 0); PG8_SCHED; PG8_LDA(At, 0, 0); PG8_STAGE(PG8_SA(1, 1), a1 + hstep, voffA);
            PG8_WAIT_L(8); PG8_BAR; PG8_WAIT_L(0); PG8_MMA(0, 0, At, B0); PG8_BAR; PG8_SCHED;
            PG8_LDB(B1, 0, 1); PG8_STAGE(PG8_SB(0, 0), b2, voffB);
            PG8_BAR; PG8_WAIT_L(0); PG8_MMA(0, 1, At, B1); PG8_BAR;
            PG8_LDA(At, 0, 1); PG8_STAGE(PG8_SA(0, 0), a2, voffA);
            PG8_BAR; PG8_WAIT_L(0); PG8_MMA(1, 0, At, B0); PG8_BAR; PG8_SCHED;
            PG8_STAGE(PG8_SB(0, 1), b2 + hstep, voffB);
            PG8_WAIT_V(6); PG8_BAR; PG8_MMA(1, 1, At, B1); PG8_BAR;
            PG8_LDB(B0, 1, 0); PG8_SCHED; PG8_LDA(At, 1, 0); PG8_STAGE(PG8_SA(0, 1), a2 + hstep, voffA);
            PG8_WAIT_L(8); PG8_BAR; PG8_WAIT_L(0); PG8_MMA(0, 0, At, B0); PG8_BAR; PG8_SCHED;
            PG8_LDB(B1, 1, 1); PG8_STAGE(PG8_SB(1, 0), b3, voffB);
            PG8_BAR; PG8_WAIT_L(0); PG8_MMA(0, 1, At, B1); PG8_BAR;
            PG8_LDA(At, 1, 1); PG8_STAGE(PG8_SA(1, 0), a3, voffA);
            PG8_BAR; PG8_WAIT_L(0); PG8_MMA(1, 0, At, B0); PG8_BAR; PG8_SCHED;
            PG8_STAGE(PG8_SB(1, 1), b3 + hstep, voffB);
            PG8_WAIT_V(6); PG8_BAR; PG8_MMA(1, 1, At, B1); PG8_BAR;
            }
        }
        if constexpr (ALIGN_EPI) { if (wr == 0) PG8_BAR; }
        if constexpr (!Epi::AFTER_DRAIN) { E(acc, cur, wr, wc, fr, fq); S.done(cur); }
        if (!has_next) break;
#pragma unroll
        for (int a = 0; a < 2; ++a)
#pragma unroll
            for (int b = 0; b < 2; ++b)
#pragma unroll
                for (int m = 0; m < 4; ++m)
#pragma unroll
                    for (int n = 0; n < 2; ++n) acc[a][b][m][n] = (f32x4){0.f, 0.f, 0.f, 0.f};
        cur = nxt; cA = nA; cB = nB; ++ui;
        if constexpr (ALIGN_EPI) { if (wr == 1) PG8_BAR; }
    }
    PG8_WAIT_V(0);
    if constexpr (!ALIGN_EPI) { if (wr == 0) PG8_BAR; }
    PG8_BAR;
    if constexpr (Epi::AFTER_DRAIN) { E.fused(acc, cur, wr, wc, fr, fq, lds, wid, lane); S.done(cur); }
#undef PG8_SA
#undef PG8_SB
#undef PG8_STAGE
#undef PG8_LDA
#undef PG8_LDB
#undef PG8_MMA
#undef PG8_WAIT_V
#undef PG8_WAIT_L
#undef PG8_BAR
#undef PG8_SCHED
}
}
namespace att {
constexpr int NW = 8, QBLK = 32, KVBLK = 64, QB = NW * QBLK, DV = 128;
constexpr int KROW = 400;
constexpr int SHM_K = KVBLK * KROW, SHM_V = KVBLK * DV * 2;
constexpr int OFF_V = 0, OFF_K = 2 * SHM_V, OFF_WS = OFF_K + 2 * SHM_K, LDS_BYTES = OFF_WS + NW * 64 * 4;
constexpr float SCALE = 0.07216878364870322f;
constexpr float THR = 8.f;
#define SBAR() __builtin_amdgcn_sched_barrier(0)
__device__ __forceinline__ int v_st(int k, int c) { const int kk = (k & ~0xC) | ((k & 4) << 1) | ((k & 8) >> 1); return ((kk >> 3) * 4 + (c >> 5)) * 512 + ((kk & 7) * 32 + (c & 31)) * 2; }
__device__ __forceinline__ int v_rd_base(int lane) { return ((lane & 3) << 3) | (((lane >> 2) & 3) << 6) | (((lane >> 4) & 1) << 5) | (((lane >> 5) & 1) << 8); }
constexpr int v_rd_off(int d0, int ks, int half) { return d0 * 512 + ks * 4096 + half * 2048; }
__device__ __forceinline__ int crow(int r, int hi) { return (r & 3) + 8 * (r >> 2) + 4 * hi; }
__device__ __forceinline__ unsigned cvtpk(float lo, float hi) { unsigned r; asm volatile("v_cvt_pk_bf16_f32 %0, %1, %2" : "=v"(r) : "v"(lo), "v"(hi)); return r; }
__device__ __forceinline__ void mask_tile(f32x16& p0, f32x16& p1, int dq) {
    const float NEG = -__builtin_inff();
#pragma unroll
    for (int r = 0; r < 16; ++r) { const int c = (r & 3) + 8 * (r >> 2);
        if (dq - c < 0) p0[r] = NEG;
        if (dq - c - 32 < 0) p1[r] = NEG; }
}
__device__ __forceinline__ void partialSM(f32x16& p0, f32x16& p1, float& m_reg, float& mn, float& alpha) {
    float pmax = p0[0];
#pragma unroll
    for (int r = 1; r < 16; ++r) pmax = fmaxf(pmax, p0[r]);
#pragma unroll
    for (int r = 0; r < 16; ++r) pmax = fmaxf(pmax, p1[r]);
    { auto rr = __builtin_amdgcn_permlane32_swap(__float_as_uint(pmax), __float_as_uint(pmax), false, false);
      pmax = fmaxf(__uint_as_float(rr[0]), __uint_as_float(rr[1])); }
    constexpr float C2 = 1.4426950408889634f * SCALE;
    if (__builtin_expect(__all((pmax - m_reg) * SCALE <= THR), 1)) { mn = m_reg; alpha = 1.f; }
    else { mn = fmaxf(m_reg, pmax); alpha = __builtin_amdgcn_exp2f((m_reg - mn) * C2); m_reg = mn; }
    const float mnL = -mn * C2;
#pragma unroll
    for (int r = 0; r < 16; ++r) p0[r] = fmaf(p0[r], C2, mnL);
#pragma unroll
    for (int r = 0; r < 16; ++r) p1[r] = fmaf(p1[r], C2, mnL);
#pragma unroll
    for (int r = 0; r < 16; ++r) p0[r] = __builtin_amdgcn_exp2f(p0[r]);
}
__device__ __forceinline__ void finishSM(f32x16& p0, f32x16& p1, float alpha, float& l_reg, bf16x8& pa0, bf16x8& pa1, bf16x8& pa2, bf16x8& pa3) {
#pragma unroll
    for (int r = 0; r < 16; ++r) p1[r] = __builtin_amdgcn_exp2f(p1[r]);
    float ps = 0;
#pragma unroll
    for (int r = 0; r < 16; ++r) ps += p0[r];
#pragma unroll
    for (int r = 0; r < 16; ++r) ps += p1[r];
    { auto rr = __builtin_amdgcn_permlane32_swap(__float_as_uint(ps), __float_as_uint(ps), false, false);
      ps = __uint_as_float(rr[0]) + __uint_as_float(rr[1]); }
    l_reg = l_reg * alpha + ps;
#define PK4(P, B_, OUT) do { unsigned a0 = cvtpk(P[B_+0], P[B_+1]), a1 = cvtpk(P[B_+2], P[B_+3]);                          \
        unsigned b0 = cvtpk(P[B_+4], P[B_+5]), b1 = cvtpk(P[B_+6], P[B_+7]);                                             \
        auto r0 = __builtin_amdgcn_permlane32_swap(a0, b0, false, false); auto r1 = __builtin_amdgcn_permlane32_swap(a1, b1, false, false); \
        u32x4 w = {r0[0], r1[0], r0[1], r1[1]}; OUT = *reinterpret_cast<bf16x8*>(&w); } while (0)
    PK4(p0, 0, pa0); PK4(p0, 8, pa1); PK4(p1, 0, pa2); PK4(p1, 8, pa3);
#undef PK4
}
__device__ __forceinline__ void qkt(f32x16& p0, f32x16& p1, const char* Kb, int r32, int hi, const bf16x8* qr) {
    p0 = f32x16{}; p1 = f32x16{};
    const char* a = Kb + r32 * KROW + hi * 16;
#pragma unroll
    for (int d0 = 0; d0 < 12; ++d0) {
        const bf16x8 b0 = *reinterpret_cast<const bf16x8*>(a + d0 * 32);
        const bf16x8 b1 = *reinterpret_cast<const bf16x8*>(a + d0 * 32 + 32 * KROW);
        p0 = __builtin_amdgcn_mfma_f32_32x32x16_bf16(b0, qr[d0], p0, 0, 0, 0);
        p1 = __builtin_amdgcn_mfma_f32_32x32x16_bf16(b1, qr[d0], p1, 0, 0, 0); }
}
__device__ __forceinline__ void pv_tile(f32x16* o, int vb0, bf16x8 pa0, bf16x8 pa1, bf16x8 pa2, bf16x8 pa3) {
#define TRRD(dst, off) asm volatile("ds_read_b64_tr_b16 %0, %1 offset:%2" : "=&v"(dst) : "v"(vb0), "i"(off) : "memory")
#define PV_D0(d0) do { s16x4 l0, l1, l2, l3, h0, h1, h2, h3; constexpr int b_ = v_rd_off(d0, 0, 0); \
        TRRD(l0, b_); TRRD(h0, b_ + 2048); TRRD(l1, b_ + 4096); TRRD(h1, b_ + 6144); TRRD(l2, b_ + 8192); TRRD(h2, b_ + 10240); TRRD(l3, b_ + 12288); TRRD(h3, b_ + 14336); \
        asm volatile("s_waitcnt lgkmcnt(0)" ::: "memory"); SBAR();   \
        o[d0] = __builtin_amdgcn_mfma_f32_32x32x16_bf16(pa0, (bf16x8){l0[0], l0[1], l0[2], l0[3], h0[0], h0[1], h0[2], h0[3]}, o[d0], 0, 0, 0);   \
        o[d0] = __builtin_amdgcn_mfma_f32_32x32x16_bf16(pa1, (bf16x8){l1[0], l1[1], l1[2], l1[3], h1[0], h1[1], h1[2], h1[3]}, o[d0], 0, 0, 0);   \
        o[d0] = __builtin_amdgcn_mfma_f32_32x32x16_bf16(pa2, (bf16x8){l2[0], l2[1], l2[2], l2[3], h2[0], h2[1], h2[2], h2[3]}, o[d0], 0, 0, 0);   \
        o[d0] = __builtin_amdgcn_mfma_f32_32x32x16_bf16(pa3, (bf16x8){l3[0], l3[1], l3[2], l3[3], h3[0], h3[1], h3[2], h3[3]}, o[d0], 0, 0, 0); } while (0)
    PV_D0(0); PV_D0(1); PV_D0(2); PV_D0(3);
#undef PV_D0
#undef TRRD
}
__device__ __forceinline__ void attn_unit(int b, int h, int qb, const bf16_t* __restrict__ Q, const bf16_t* __restrict__ KVp, const bf16_t* __restrict__ KR, bf16_t* __restrict__ O, char* lds) {
    int tid_o = threadIdx.x; asm volatile("" : "+v"(tid_o)); const int tid = tid_o, wid = __builtin_amdgcn_readfirstlane(tid >> 6), lane = tid & 63, r32 = lane & 31, hi = lane >> 5;
    const size_t rowbase = (size_t)b * SEQ; const int q0 = qb * QB;
    char* V_lds = lds + OFF_V; char* K_lds = lds + OFF_K;
    float* ws = (float*)(lds + OFF_WS) + wid * 64; float* li_l = ws; float* al_l = ws + 32;
    bf16x8 qr[12];
    { const bf16_t* Qw = Q + (rowbase + q0 + wid * QBLK + r32) * NQ + h * DQK + hi * 8;
#pragma unroll
      for (int d0 = 0; d0 < 12; ++d0) qr[d0] = *reinterpret_cast<const bf16x8*>(Qw + d0 * 16); }
    const bf16_t* ksrc[3]; int kstr[3], kdst[3];
#pragma unroll
    for (int i = 0; i < 3; ++i) { const int c = tid + 512 * i, kr = c / 24, kc = c - kr * 24;
        if (kc < 16) { ksrc[i] = KVp + (rowbase + kr) * NKV + h * 256 + kc * 8; kstr[i] = KVBLK * NKV; }
        else { ksrc[i] = KR + (rowbase + kr) * 64 + (kc - 16) * 8; kstr[i] = KVBLK * 64; }
        kdst[i] = kr * KROW + kc * 16; }
    const int sr = tid >> 4, sc = (tid & 15) * 8;
    const bf16_t* vsrc = KVp + (rowbase + sr) * NKV + h * 256 + 128 + sc;
    const int vst0 = v_st(sr, sc), vst1 = v_st(32 + sr, sc);
    const int vb0 = (int)(uintptr_t)V_lds + v_rd_base(lane);
    const int NT = 4 * qb + 4;
    const int qlo = q0 + wid * QBLK, qm = qlo + r32 - 4 * hi;
    bf16x8 sk0, sk1, sk2, sv0, sv1;
#define SLOAD(t) do { sk0 = *reinterpret_cast<const bf16x8*>(ksrc[0] + (size_t)(t) * kstr[0]); sk1 = *reinterpret_cast<const bf16x8*>(ksrc[1] + (size_t)(t) * kstr[1]); \
        sk2 = *reinterpret_cast<const bf16x8*>(ksrc[2] + (size_t)(t) * kstr[2]); \
        sv0 = *reinterpret_cast<const bf16x8*>(vsrc + (size_t)(t) * KVBLK * NKV); sv1 = *reinterpret_cast<const bf16x8*>(vsrc + (size_t)(t) * KVBLK * NKV + 32 * NKV); } while (0)
#define SWRITE(bf) do { *reinterpret_cast<bf16x8*>(K_lds + (bf) * SHM_K + kdst[0]) = sk0; *reinterpret_cast<bf16x8*>(K_lds + (bf) * SHM_K + kdst[1]) = sk1; \
        *reinterpret_cast<bf16x8*>(K_lds + (bf) * SHM_K + kdst[2]) = sk2; \
        *reinterpret_cast<bf16x8*>(V_lds + (bf) * SHM_V + vst0) = sv0; *reinterpret_cast<bf16x8*>(V_lds + (bf) * SHM_V + vst1) = sv1; } while (0)
    SLOAD(0); SWRITE(0); __syncthreads();
    float m_reg = -1e30f, l_reg = 0.f; f32x16 o[4];
#pragma unroll
    for (int d = 0; d < 4; ++d) o[d] = f32x16{};
    for (int t = 0; t < NT; ++t) {
        const int cur = t & 1;
        if (t + 1 < NT) { SLOAD(t + 1); } SBAR();
        f32x16 p0, p1; float mn, alpha; bf16x8 pa0, pa1, pa2, pa3;
        qkt(p0, p1, K_lds + cur * SHM_K, r32, hi, qr);
        const int kb = t * KVBLK;
        if (kb + KVBLK - 1 > qlo) mask_tile(p0, p1, qm - kb);
        partialSM(p0, p1, m_reg, mn, alpha);
        if (__any(alpha < 1.f)) { if (hi == 0) al_l[r32] = alpha; asm volatile("s_waitcnt lgkmcnt(0)" ::: "memory");
#pragma unroll
            for (int d_ = 0; d_ < 4; ++d_)
#pragma unroll
                for (int r = 0; r < 16; ++r) o[d_][r] *= al_l[crow(r, hi)]; }
        finishSM(p0, p1, alpha, l_reg, pa0, pa1, pa2, pa3); SBAR();
        pv_tile(o, vb0 + cur * SHM_V, pa0, pa1, pa2, pa3);
        if (t + 1 < NT) { SWRITE(cur ^ 1); }
        __syncthreads();
    }
    if (hi == 0) li_l[r32] = l_reg; asm volatile("s_waitcnt lgkmcnt(0)" ::: "memory");
    float rli[16];
#pragma unroll
    for (int r = 0; r < 16; ++r) rli[r] = __builtin_amdgcn_rcpf(li_l[crow(r, hi)]);
    bf16_t* Ow = O + (rowbase + q0 + wid * QBLK) * DM + h * DV;
#pragma unroll
    for (int r = 0; r < 16; ++r) { const int orow = crow(r, hi);
#pragma unroll
        for (int d0 = 0; d0 < 4; ++d0) { const float v = o[d0][r] * rli[r]; const float vn = __shfl_xor(v, 1);
            if ((r32 & 1) == 0) *(unsigned*)(Ow + (size_t)orow * DM + d0 * 32 + r32) = cvtpk(v, vn); } }
    __syncthreads();
#undef SLOAD
#undef SWRITE
}
#undef SBAR
}
#define XB_TMO      128
#define XB_XCNT(j)  (256  + 64 * (j))
#define XB_XSUB(j)  (1280 + 64 * (j))
#define XB_XGEN(j)  (2304 + 64 * (j))
#define XB_TOP      3328
#define XB_TOPGEN   3392
#define XCD_BAR_WORDS 3456
#define XB_SPIN_CAP (1u << 18)

__device__ __forceinline__ unsigned xb_ld(unsigned* p)              { return __hip_atomic_load(p, __ATOMIC_RELAXED, __HIP_MEMORY_SCOPE_AGENT); }
__device__ __forceinline__ unsigned xb_add(unsigned* p, unsigned v) { return __hip_atomic_fetch_add(p, v, __ATOMIC_RELAXED, __HIP_MEMORY_SCOPE_AGENT); }
__device__ __forceinline__ unsigned xb_xcc_id() { return (unsigned)__builtin_amdgcn_s_getreg((3 << 11) | 20) & 0xFu; }
#define XB_SPIN(cond, bar) do { unsigned _sp = 0; while (cond) { __builtin_amdgcn_s_sleep(1); \
    if ((++_sp & 255u) == 0u) { if (xb_ld(&(bar)[XB_TMO])) break; if (_sp > XB_SPIN_CAP) { atomicAdd(&(bar)[XB_TMO], 1u); break; } } } } while (0)

struct XcdBarrier {
    unsigned* bar; unsigned x;
    volatile LAS unsigned* st;
};

__device__ __forceinline__ XcdBarrier xcd_barrier_post(unsigned* bar, volatile LAS unsigned* st) {
    XcdBarrier b; b.bar = bar; b.x = xb_xcc_id(); b.st = st;
    if (threadIdx.x == 0) (void)xb_add(&bar[XB_XCNT(b.x)], 1u);
    return b;
}
__device__ __forceinline__ void xcd_barrier_complete(unsigned* bar, unsigned x, unsigned& nloc, unsigned& nx) {
    const unsigned G = gridDim.x * gridDim.y * gridDim.z;
    unsigned sum, cnt, mine, sp = 0u;
    for (;;) {
        sum = 0u; cnt = 0u; mine = 0u;
#pragma unroll
        for (unsigned j = 0; j < 16; ++j) { const unsigned c = xb_ld(&bar[XB_XCNT(j)]); sum += c; cnt += (c > 0u) ? 1u : 0u; mine = (j == x) ? c : mine; }
        if (sum == G) break;
        __builtin_amdgcn_s_sleep(1);
        if ((++sp & 255u) == 0u) { if (xb_ld(&bar[XB_TMO])) break; if (sp > XB_SPIN_CAP) { atomicAdd(&bar[XB_TMO], 1u); break; } }
    }
    nloc = mine > 0u ? mine : 1u; nx = cnt > 0u ? cnt : 1u;
}

__device__ __forceinline__ void xcd_barrier(const XcdBarrier& b) {
    asm volatile("s_waitcnt vmcnt(0)" ::: "memory");
    __syncthreads();
    if (threadIdx.x == 0) {
        unsigned* bar = b.bar;
        __builtin_amdgcn_s_waitcnt(0);
        unsigned nloc = b.st[0], nx = b.st[1];
        if (nloc == 0u) { xcd_barrier_complete(bar, b.x, nloc, nx); b.st[0] = nloc; b.st[1] = nx; }
        const unsigned old = xb_add(&bar[XB_XSUB(b.x)], 1u);
        const unsigned gen = old / nloc;
        if (old + 1u == (gen + 1u) * nloc) {
            __builtin_amdgcn_fence(__ATOMIC_RELEASE, "agent");
            asm volatile("s_waitcnt vmcnt(0)" ::: "memory");
            const unsigned og = xb_add(&bar[XB_TOP], 1u);
            const unsigned tg = og / nx;
            if (og + 1u == (tg + 1u) * nx) xb_add(&bar[XB_TOPGEN], 1u);
            else XB_SPIN(xb_ld(&bar[XB_TOPGEN]) == tg, bar);
            __builtin_amdgcn_fence(__ATOMIC_ACQUIRE, "agent");
            xb_add(&bar[XB_XGEN(b.x)], 1u);
            asm volatile("s_waitcnt vmcnt(0)" ::: "memory");
        } else {
            XB_SPIN(xb_ld(&bar[XB_XGEN(b.x)]) == gen, bar);
            __builtin_amdgcn_fence(__ATOMIC_ACQUIRE, "agent");
            asm volatile("s_waitcnt vmcnt(0)" ::: "memory");
        }
    }
    __syncthreads();
}
using pg8::Gemm; using pg8::StaticOrder; using pg8::gemm_phase;
#define LDS_WAIT() asm volatile("s_waitcnt lgkmcnt(0)" ::: "memory")
constexpr int NWAVES = 8, NTHREADS = 512;
constexpr int LDS_BYTES = 135168;

__device__ __forceinline__ float wave_sum(float v) {
#pragma unroll
    for (int o = 1; o < 64; o <<= 1) v += __shfl_xor(v, o);
    return v;
}
__device__ __forceinline__ unsigned pk2(float lo, float hi) { return pg8::cvt_pk_bf16(lo, hi); }
__device__ __forceinline__ float bflo(unsigned u) { return __uint_as_float(u << 16); }
__device__ __forceinline__ float bfhi(unsigned u) { return __uint_as_float(u & 0xffff0000u); }
__device__ __forceinline__ void unpack8(const u32x4 w, float* f) { f[0] = bflo(w.x); f[1] = bfhi(w.x); f[2] = bflo(w.y); f[3] = bfhi(w.y); f[4] = bflo(w.z); f[5] = bfhi(w.z); f[6] = bflo(w.w); f[7] = bfhi(w.w); }
__device__ __forceinline__ u32x4 pack8f(const float* f) { u32x4 w; w.x = pk2(f[0], f[1]); w.y = pk2(f[2], f[3]); w.z = pk2(f[4], f[5]); w.w = pk2(f[6], f[7]); return w; }

template <int MAP> __device__ __forceinline__ int wmap(int n) {
    if (MAP == 1) { return n < 1280 ? n : (n < 1344 ? n + (PC_KR - 1280) : n - 64); }
    if (MAP == 2) { const int h = n / 192, w = n - h * 192; if (w < 128) return n; const int j = w - 128;
                    return h * 192 + 128 + (j < 32 ? 2 * j : 2 * (j - 32) + 1); }
    if (MAP == 3) { if (n < DFF) return (n >> 7) * 256 + (n & 127); const int n2 = n - DFF; return (n2 >> 7) * 256 + 128 + (n2 & 127); }
    return n;
}
template <int MAP> __device__ __forceinline__ void transpose_item(const float* __restrict__ W, int K, int N, bf16_t* __restrict__ WT, LAS float* scr, int item, int lane) {
    const int nblk = N / 32, kb = item / nblk, nb = item - kb * nblk, k0 = 64 * kb, n0 = 32 * nb;
    { const int lr = lane >> 3, lc = (lane & 7) * 4; f32x4 v[8];
#pragma unroll
      for (int i = 0; i < 8; ++i) v[i] = *(const f32x4*)(W + (size_t)(k0 + i * 8 + lr) * N + n0 + lc);
#pragma unroll
      for (int i = 0; i < 8; ++i) { LAS float* sp = scr + (i * 8 + lr) * 33 + lc; sp[0] = v[i][0]; sp[1] = v[i][1]; sp[2] = v[i][2]; sp[3] = v[i][3]; } }
    LDS_WAIT(); asm volatile("" ::: "memory");
    const int c = lane & 7;
#pragma unroll
    for (int j = 0; j < 4; ++j) { const int n = (lane >> 3) + 8 * j; const LAS float* s = scr + (8 * c) * 33 + n;
        u32x4 o; o.x = pk2(s[0 * 33], s[1 * 33]); o.y = pk2(s[2 * 33], s[3 * 33]); o.z = pk2(s[4 * 33], s[5 * 33]); o.w = pk2(s[6 * 33], s[7 * 33]);
        *(u32x4*)(WT + (size_t)wmap<MAP>(n0 + n) * K + k0 + 8 * c) = o; }
    LDS_WAIT(); asm volatile("" ::: "memory");
}

struct Args {
    const float* x; const float* c; const int* pos; const float* w_ada; const float* b_ada; const float* g_pre_mix; const float* g_post_mix;
    const float* w_in; const float* g_q; const float* w_uq; const float* g_kv; const float* w_ukv; const float* conv_w_mix; const float* conv_b_mix;
    const float* w_o; const float* g_pre_ffn; const float* g_post_ffn; const float* w_up; const float* conv_w_ffn; const float* conv_b_ffn; const float* w_down;
    float* out; unsigned char* ws;
};

__device__ __forceinline__ void ph_prologue(const Args& a, LAS unsigned char* lds, int G) {
    int tid_o = threadIdx.x; asm volatile("" : "+v"(tid_o)); const int tid = tid_o, lane = tid & 63, wave = tid >> 6;
    unsigned char* ws = a.ws;
    float* MOD = (float*)(ws + WS_MOD);
    for (int it = blockIdx.x; it < NMODC / 64; it += G) {
        LAS float* red = (LAS float*)lds;
        const int kg = tid >> 4, l16 = tid & 15, col = it * 64 + l16 * 4;
        f32x4 a0 = {0.f, 0.f, 0.f, 0.f}, a1 = {0.f, 0.f, 0.f, 0.f};
#pragma unroll 8
        for (int i = 0; i < 64; ++i) { const int k = kg + 32 * i;
            const f32x4 w = *(const f32x4*)(a.w_ada + (size_t)k * NMODC + col);
            const float c0 = a.c[k], c1 = a.c[DM + k];
            const float s0 = c0 / (1.f + __expf(-c0)), s1 = c1 / (1.f + __expf(-c1));
            a0 += w * s0; a1 += w * s1; }
        LAS float* rp = red + (kg * 16 + l16) * 8;
        rp[0] = a0[0]; rp[1] = a0[1]; rp[2] = a0[2]; rp[3] = a0[3]; rp[4] = a1[0]; rp[5] = a1[1]; rp[6] = a1[2]; rp[7] = a1[3];
        __syncthreads();
        if (tid < 128) { const int b = tid >> 6, cc = tid & 63; float s = 0.f;
            for (int g = 0; g < 32; ++g) s += red[(g * 16 + (cc >> 2)) * 8 + b * 4 + (cc & 3)];
            MOD[b * NMODC + it * 64 + cc] = s + a.b_ada[it * 64 + cc]; }
        __syncthreads();
    }
    LAS float* scr = (LAS float*)(lds + wave * 16384);
    const int gw = blockIdx.x * NWAVES + wave, NGW = G * NWAVES;
    bf16_t* WinT = (bf16_t*)(ws + WS_WIN); bf16_t* WuqT = (bf16_t*)(ws + WS_WUQ); bf16_t* WukvT = (bf16_t*)(ws + WS_WUKV);
    bf16_t* WoT = (bf16_t*)(ws + WS_WO); bf16_t* WupT = (bf16_t*)(ws + WS_WUP); bf16_t* WdnT = (bf16_t*)(ws + WS_WDN);
    constexpr int I_IN = (DM / 64) * (INC / 32), I_UQ = (QL / 64) * (NQ / 32), I_UKV = (KVL / 64) * (NKV / 32), I_O = (DM / 64) * (DM / 32), I_UP = (DM / 64) * (NUP / 32), I_DN = (DFF / 64) * (DM / 32);
    constexpr int NITEMS = I_IN + I_UQ + I_UKV + I_O + I_UP + I_DN;
    for (int it = gw; it < NITEMS; it += NGW) {
        int r = it;
        if (r < I_UP) { transpose_item<3>(a.w_up, DM, NUP, WupT, scr, r, lane); continue; } r -= I_UP;
        if (r < I_DN) { transpose_item<0>(a.w_down, DFF, DM, WdnT, scr, r, lane); continue; } r -= I_DN;
        if (r < I_IN) { transpose_item<1>(a.w_in, DM, INC, WinT, scr, r, lane); continue; } r -= I_IN;
        if (r < I_O) { transpose_item<0>(a.w_o, DM, DM, WoT, scr, r, lane); continue; } r -= I_O;
        if (r < I_UQ) { transpose_item<2>(a.w_uq, QL, NQ, WuqT, scr, r, lane); continue; } r -= I_UQ;
        transpose_item<0>(a.w_ukv, KVL, NKV, WukvT, scr, r, lane);
    }
    const int gt = blockIdx.x * NTHREADS + tid, NGT = G * NTHREADS;
    { u32x4* z = (u32x4*)(WinT + (size_t)INC * DM); const int nz = (INP - INC) * DM / 8;
      for (int i = gt; i < nz; i += NGT) z[i] = (u32x4){0u, 0u, 0u, 0u}; }
    { f32x2* CS = (f32x2*)(ws + WS_CS);
      for (int i = gt; i < M * 32; i += NGT) { const int row = i >> 5, j = i & 31;
          const float inv = 1.0f / exp2f((float)(2 * j) * (13.287712379549449f / 64.f));
          const float ang = (float)a.pos[row] * inv;
          const double rv = (double)ang * 0.15915494309189535; const float f = (float)(rv - __builtin_rint(rv));
          CS[i] = (f32x2){__builtin_amdgcn_cosf(f), __builtin_amdgcn_sinf(f)}; } }
}

__device__ __forceinline__ void ph_prenorm(const float* __restrict__ x, const float* __restrict__ g, const float* __restrict__ mod, int sh_i, int sc_i, bf16_t* __restrict__ XN, int gw, int NGW, int lane) {
    for (int row = gw; row < M; row += NGW) {
        const float* mb = mod + (row >= SEQ ? NMODC : 0);
        const f32x4* xr = (const f32x4*)(x + (size_t)row * DM) + lane;
        f32x4 v[8]; float ss = 0.f;
#pragma unroll
        for (int j = 0; j < 8; ++j) { v[j] = xr[64 * j]; ss += (v[j][0] * v[j][0] + v[j][1] * v[j][1]) + (v[j][2] * v[j][2] + v[j][3] * v[j][3]); }
        const float rstd = rsqrtf(wave_sum(ss) * (1.f / DM) + RMS_EPS);
#pragma unroll
        for (int j = 0; j < 8; ++j) { const int e = (lane + 64 * j) * 4;
            const f32x4 g4 = *(const f32x4*)(g + e), s4 = *(const f32x4*)(mb + sc_i * DM + e), h4 = *(const f32x4*)(mb + sh_i * DM + e);
            const f32x4 o = v[j] * rstd * g4 * (s4 + 1.f) + h4;
            *(u32x2*)(XN + (size_t)row * DM + e) = (u32x2){pk2(o[0], o[1]), pk2(o[2], o[3])}; }
    }
}

__device__ __forceinline__ void ph_mid(const Args& a, int gw, int NGW, int lane) {
    unsigned char* ws = a.ws;
    const bf16_t* PROJ = (const bf16_t*)(ws + WS_PROJ); const float* CS = (const float*)(ws + WS_CS);
    bf16_t* QN = (bf16_t*)(ws + WS_QN); bf16_t* KVN = (bf16_t*)(ws + WS_KVN); bf16_t* KR = (bf16_t*)(ws + WS_KR); bf16_t* MIXIN = (bf16_t*)(ws + WS_XN);
    for (int row = gw; row < M; row += NGW) {
        const bf16_t* pr = PROJ + (size_t)row * INP;
        {
            float f[3][4]; float ss = 0.f;
#pragma unroll
            for (int j = 0; j < 3; ++j) { const u32x2 w = *(const u32x2*)(pr + PC_Q + (lane + 64 * j) * 4);
                f[j][0] = bflo(w.x); f[j][1] = bfhi(w.x); f[j][2] = bflo(w.y); f[j][3] = bfhi(w.y);
                ss += (f[j][0] * f[j][0] + f[j][1] * f[j][1]) + (f[j][2] * f[j][2] + f[j][3] * f[j][3]); }
            const float rstd = rsqrtf(wave_sum(ss) * (1.f / QL) + RMS_EPS);
#pragma unroll
            for (int j = 0; j < 3; ++j) { const int e = (lane + 64 * j) * 4; const f32x4 g4 = *(const f32x4*)(a.g_q + e);
                *(u32x2*)(QN + (size_t)row * QL + e) = (u32x2){pk2(f[j][0] * rstd * g4[0], f[j][1] * rstd * g4[1]), pk2(f[j][2] * rstd * g4[2], f[j][3] * rstd * g4[3])}; }
        }
        {
            float f[8]; unpack8(*(const u32x4*)(pr + PC_KV + lane * 8), f); float ss = 0.f;
#pragma unroll
            for (int i = 0; i < 8; ++i) ss += f[i] * f[i];
            const float rstd = rsqrtf(wave_sum(ss) * (1.f / KVL) + RMS_EPS);
            const f32x4 g0 = *(const f32x4*)(a.g_kv + lane * 8), g1 = *(const f32x4*)(a.g_kv + lane * 8 + 4);
#pragma unroll
            for (int i = 0; i < 4; ++i) { f[i] *= rstd * g0[i]; f[4 + i] *= rstd * g1[i]; }
            *(u32x4*)(KVN + (size_t)row * KVL + lane * 8) = pack8f(f);
        }
        if (lane < 32) {
            const float x1 = __uint_as_float((unsigned)pr[PC_KR + lane] << 16), x2 = __uint_as_float((unsigned)pr[PC_KR + 32 + lane] << 16);
            const f32x2 cs = *(const f32x2*)(CS + (size_t)row * 64 + 2 * lane);
            *(unsigned*)(KR + (size_t)row * 64 + 2 * lane) = pk2(x1 * cs.x - x2 * cs.y, x2 * cs.x + x1 * cs.y);
        }
        const int tt = row & (SEQ - 1);
#pragma unroll
        for (int j = 0; j < 2; ++j) {
            const int c0 = lane * 8 + 512 * j;
            float gb[8], p0[8], p1[8], p2[8], t0[8], t1[8];
            unpack8(*(const u32x4*)(pr + PC_GB + c0), gb);
            unpack8(*(const u32x4*)(pr + PC_GC + c0), t0); unpack8(*(const u32x4*)(pr + PC_CI + c0), t1);
#pragma unroll
            for (int i = 0; i < 8; ++i) p0[i] = t0[i] * t1[i];
            if (tt >= 1) { unpack8(*(const u32x4*)(pr - INP + PC_GC + c0), t0); unpack8(*(const u32x4*)(pr - INP + PC_CI + c0), t1); }
#pragma unroll
            for (int i = 0; i < 8; ++i) p1[i] = tt >= 1 ? t0[i] * t1[i] : 0.f;
            if (tt >= 2) { unpack8(*(const u32x4*)(pr - 2 * INP + PC_GC + c0), t0); unpack8(*(const u32x4*)(pr - 2 * INP + PC_CI + c0), t1); }
#pragma unroll
            for (int i = 0; i < 8; ++i) p2[i] = tt >= 2 ? t0[i] * t1[i] : 0.f;
            float o[8];
#pragma unroll
            for (int i = 0; i < 8; ++i) { const float w0 = a.conv_w_mix[c0 + i], w1 = a.conv_w_mix[CW + c0 + i], w2 = a.conv_w_mix[2 * CW + c0 + i], bb = a.conv_b_mix[c0 + i];
                o[i] = gb[i] * (w0 * p2[i] + w1 * p1[i] + w2 * p0[i] + bb); }
            *(u32x4*)(MIXIN + (size_t)row * DM + CW + c0) = pack8f(o);
        }
    }
}

__device__ __forceinline__ void ph_post_mix(const Args& a, int gw, int NGW, int lane) {
    unsigned char* ws = a.ws; const bf16_t* MIX = (const bf16_t*)(ws + WS_PROJ); const float* mod = (const float*)(ws + WS_MOD); bf16_t* XN2 = (bf16_t*)(ws + WS_XN);
    for (int row = gw; row < M; row += NGW) {
        const float* mb = mod + (row >= SEQ ? NMODC : 0);
        const f32x4* xr = (const f32x4*)(a.x + (size_t)row * DM) + 2 * lane;
        f32x4 v[8], xv[8]; float ss = 0.f;
#pragma unroll
        for (int j = 0; j < 4; ++j) { const u32x4 w = *(const u32x4*)(MIX + (size_t)row * DM + (lane + 64 * j) * 8); xv[2 * j] = xr[128 * j]; xv[2 * j + 1] = xr[128 * j + 1];
            v[2 * j] = (f32x4){bflo(w.x), bfhi(w.x), bflo(w.y), bfhi(w.y)}; v[2 * j + 1] = (f32x4){bflo(w.z), bfhi(w.z), bflo(w.w), bfhi(w.w)}; }
#pragma unroll
        for (int j = 0; j < 8; ++j) ss += (v[j][0] * v[j][0] + v[j][1] * v[j][1]) + (v[j][2] * v[j][2] + v[j][3] * v[j][3]);
        const float rstd = rsqrtf(wave_sum(ss) * (1.f / DM) + RMS_EPS);
        float ss2 = 0.f;
#pragma unroll
        for (int j = 0; j < 8; ++j) { const int e = (lane + 64 * (j >> 1)) * 8 + (j & 1) * 4;
            const f32x4 g4 = *(const f32x4*)(a.g_post_mix + e), gt = *(const f32x4*)(mb + 2 * DM + e);
            const f32x4 x1 = xv[j] + gt * (v[j] * rstd * g4);
            *(f32x4*)(a.out + (size_t)row * DM + e) = x1; v[j] = x1;
            ss2 += (x1[0] * x1[0] + x1[1] * x1[1]) + (x1[2] * x1[2] + x1[3] * x1[3]); }
        const float rstd2 = rsqrtf(wave_sum(ss2) * (1.f / DM) + RMS_EPS);
#pragma unroll
        for (int j = 0; j < 4; ++j) { const int e = (lane + 64 * j) * 8; f32x4 o[2];
#pragma unroll
            for (int hh = 0; hh < 2; ++hh) { const f32x4 g4 = *(const f32x4*)(a.g_pre_ffn + e + 4 * hh), s4 = *(const f32x4*)(mb + 4 * DM + e + 4 * hh), h4 = *(const f32x4*)(mb + 3 * DM + e + 4 * hh);
                o[hh] = v[2 * j + hh] * rstd2 * g4 * (s4 + 1.f) + h4; }
            *(u32x4*)(XN2 + (size_t)row * DM + e) = (u32x4){pk2(o[0][0], o[0][1]), pk2(o[0][2], o[0][3]), pk2(o[1][0], o[1][1]), pk2(o[1][2], o[1][3])}; }
    }
}

__device__ __forceinline__ void ph_act(const Args& a, int t0, int ntiles, int gt, int NGT) {
    unsigned char* ws = a.ws; const bf16_t* U = (const bf16_t*)(ws + WS_U); bf16_t* ACT = (bf16_t*)(ws + WS_ACT);
    const int Np = ntiles * 256, nch = ntiles * 16, total = (M / 8) * nch;
    for (int idx = gt; idx < total; idx += NGT) {
        const int rb = idx / nch, ch = idx - rb * nch, tile = ch >> 4, cc = ch & 15;
        const int ucol = tile * 256 + cc * 8, acol = (t0 + tile) * 128 + cc * 8;
        float wa[3][8], wg[3][8], ba[8], bg[8];
#pragma unroll
        for (int k = 0; k < 3; ++k) {
            const f32x4 q0 = *(const f32x4*)(a.conv_w_ffn + k * NUP + acol), q1 = *(const f32x4*)(a.conv_w_ffn + k * NUP + acol + 4);
            const f32x4 r0 = *(const f32x4*)(a.conv_w_ffn + k * NUP + DFF + acol), r1 = *(const f32x4*)(a.conv_w_ffn + k * NUP + DFF + acol + 4);
#pragma unroll
            for (int i = 0; i < 4; ++i) { wa[k][i] = q0[i]; wa[k][4 + i] = q1[i]; wg[k][i] = r0[i]; wg[k][4 + i] = r1[i]; } }
        { const f32x4 q0 = *(const f32x4*)(a.conv_b_ffn + acol), q1 = *(const f32x4*)(a.conv_b_ffn + acol + 4);
          const f32x4 r0 = *(const f32x4*)(a.conv_b_ffn + DFF + acol), r1 = *(const f32x4*)(a.conv_b_ffn + DFF + acol + 4);
#pragma unroll
          for (int i = 0; i < 4; ++i) { ba[i] = q0[i]; ba[4 + i] = q1[i]; bg[i] = r0[i]; bg[4 + i] = r1[i]; } }
        const int r0w = rb * 8; const bool first = (r0w & (SEQ - 1)) == 0;
        float a1[8], a2[8], g1[8], g2[8];
#pragma unroll
        for (int i = 0; i < 8; ++i) { a1[i] = 0.f; a2[i] = 0.f; g1[i] = 0.f; g2[i] = 0.f; }
        if (!first) { const bf16_t* up = U + (size_t)(r0w - 2) * Np + ucol;
            unpack8(*(const u32x4*)up, a2); unpack8(*(const u32x4*)(up + 128), g2); unpack8(*(const u32x4*)(up + Np), a1); unpack8(*(const u32x4*)(up + Np + 128), g1); }
#pragma unroll
        for (int r = 0; r < 8; ++r) { const bf16_t* up = U + (size_t)(r0w + r) * Np + ucol;
            float a0[8], g0[8], o[8]; unpack8(*(const u32x4*)up, a0); unpack8(*(const u32x4*)(up + 128), g0);
#pragma unroll
            for (int i = 0; i < 8; ++i) { const float ua = wa[0][i] * a2[i] + wa[1][i] * a1[i] + wa[2][i] * a0[i] + ba[i];
                const float ug = wg[0][i] * g2[i] + wg[1][i] * g1[i] + wg[2][i] * g0[i] + bg[i];
                o[i] = ua * ug * __builtin_amdgcn_rcpf(1.f + __expf(-ug)); a2[i] = a1[i]; a1[i] = a0[i]; g2[i] = g1[i]; g1[i] = g0[i]; }
            *(u32x4*)(ACT + (size_t)(r0w + r) * DFF + acol) = pack8f(o); }
    }
}

__device__ __forceinline__ void ph_final(const Args& a, int gw, int NGW, int lane) {
    unsigned char* ws = a.ws; const bf16_t* Y = (const bf16_t*)(ws + WS_Y); const float* mod = (const float*)(ws + WS_MOD);
    for (int row = gw; row < M; row += NGW) {
        const float* mb = mod + (row >= SEQ ? NMODC : 0);
        const f32x4* xr = (const f32x4*)(a.out + (size_t)row * DM) + 2 * lane;
        f32x4 v[8], xv[8]; float ss = 0.f;
#pragma unroll
        for (int j = 0; j < 4; ++j) { const u32x4 w = *(const u32x4*)(Y + (size_t)row * DM + (lane + 64 * j) * 8); xv[2 * j] = xr[128 * j]; xv[2 * j + 1] = xr[128 * j + 1];
            v[2 * j] = (f32x4){bflo(w.x), bfhi(w.x), bflo(w.y), bfhi(w.y)}; v[2 * j + 1] = (f32x4){bflo(w.z), bfhi(w.z), bflo(w.w), bfhi(w.w)}; }
#pragma unroll
        for (int j = 0; j < 8; ++j) ss += (v[j][0] * v[j][0] + v[j][1] * v[j][1]) + (v[j][2] * v[j][2] + v[j][3] * v[j][3]);
        const float rstd = rsqrtf(wave_sum(ss) * (1.f / DM) + RMS_EPS);
#pragma unroll
        for (int j = 0; j < 8; ++j) { const int e = (lane + 64 * (j >> 1)) * 8 + (j & 1) * 4;
            const f32x4 g4 = *(const f32x4*)(a.g_post_ffn + e), gt = *(const f32x4*)(mb + 5 * DM + e);
            *(f32x4*)(a.out + (size_t)row * DM + e) = xv[j] + gt * (v[j] * rstd * g4); }
    }
}

#ifndef PROBE_THIN
#define PROBE_THIN 1
#endif
#ifndef PROBE_ATT
#define PROBE_ATT 1
#endif
constexpr int LDS_MISC = 131072 + 256;
constexpr size_t WS_BAR = 67 * MiB, BAR_BYTES = 16384;
__global__ void __launch_bounds__(NTHREADS, 2) mega_fwd(Args a) {
    extern __shared__ __attribute__((aligned(16))) unsigned char lds_raw[];
    cg::grid_group grid = cg::this_grid();
    LAS unsigned char* lds = (LAS unsigned char*)lds_raw;
    const int tid = threadIdx.x, lane = tid & 63, wave = __builtin_amdgcn_readfirstlane(tid >> 6);
    const int G = gridDim.x, bid = blockIdx.x;
    const int gw = bid * NWAVES + wave, NGW = G * NWAVES, gt = bid * NTHREADS + tid, NGT = G * NTHREADS;
    unsigned char* ws = a.ws;
    bf16_t* XN = (bf16_t*)(ws + WS_XN);
    volatile LAS unsigned* misc = (volatile LAS unsigned*)(lds + LDS_MISC);
    if (tid < 2) misc[tid] = 0u;
    __syncthreads();
    const XcdBarrier xbar = xcd_barrier_post((unsigned*)(ws + WS_BAR), misc);
    if (a.out == nullptr) grid.sync();
#define GRID_BAR() xcd_barrier(xbar)

    ph_prologue(a, lds, G);
    GRID_BAR();
    for (int rep = 0; rep < PROBE_THIN; ++rep) ph_prenorm(a.x, a.g_pre_mix, (const float*)(ws + WS_MOD), 0, 1, XN, gw, NGW, lane);
    GRID_BAR();
    {
        Gemm g{XN, (const bf16_t*)(ws + WS_WIN), M, INP, DM}; StaticOrder S; S.init(M, INP, G, bid);
        pg8::EpiBf16 E{(bf16_t*)(ws + WS_PROJ), INP};
        gemm_phase<pg8::EpiBf16, StaticOrder, true, true>(lds, g, S, E);
    }
    GRID_BAR();
    for (int rep = 0; rep < PROBE_THIN; ++rep) ph_mid(a, gw, NGW, lane);
    GRID_BAR();
    {
        Gemm g{(const bf16_t*)(ws + WS_QN), (const bf16_t*)(ws + WS_WUQ), M, NQ, QL}; StaticOrder S; S.init(M, NQ, G, bid);
        pg8::EpiQ E{(bf16_t*)(ws + WS_Q), (const float*)(ws + WS_CS)};
        gemm_phase<pg8::EpiQ, StaticOrder, true, true>(lds, g, S, E);
        Gemm g2{(const bf16_t*)(ws + WS_KVN), (const bf16_t*)(ws + WS_WUKV), M, NKV, KVL}; StaticOrder S2; S2.init(M, NKV, G, bid);
        pg8::EpiBf16 E2{(bf16_t*)(ws + WS_KV), NKV};
        gemm_phase<pg8::EpiBf16, StaticOrder, true, true>(lds, g2, S2, E2);
    }
    GRID_BAR();
    {
        for (int rep = 0; rep < PROBE_ATT; ++rep)
        for (int L = bid; L < 256; L += G) {
            const int v = (L & 7) * 32 + (L >> 3), bh = v >> 4, s = v & 15;
            att::attn_unit(bh >> 3, bh & 7, 31 - s, (const bf16_t*)(ws + WS_Q), (const bf16_t*)(ws + WS_KV), (const bf16_t*)(ws + WS_KR), XN, (char*)lds_raw);
            att::attn_unit(bh >> 3, bh & 7, s, (const bf16_t*)(ws + WS_Q), (const bf16_t*)(ws + WS_KV), (const bf16_t*)(ws + WS_KR), XN, (char*)lds_raw);
        }
    }
    GRID_BAR();
    {
        Gemm g{XN, (const bf16_t*)(ws + WS_WO), M, DM, DM}; StaticOrder S; S.init(M, DM, G, bid);
        pg8::EpiBf16 E{(bf16_t*)(ws + WS_PROJ), DM};
        gemm_phase<pg8::EpiBf16, StaticOrder, true, true>(lds, g, S, E);
    }
    GRID_BAR();
    for (int rep = 0; rep < PROBE_THIN; ++rep) ph_post_mix(a, gw, NGW, lane);
    GRID_BAR();
    {
        Gemm g{XN, (const bf16_t*)(ws + WS_WUP), M, UP_TA * 256, DM}; StaticOrder S; S.init(M, UP_TA * 256, G, bid);
        pg8::EpiBf16 E{(bf16_t*)(ws + WS_U), UP_TA * 256};
        gemm_phase<pg8::EpiBf16, StaticOrder, true, true>(lds, g, S, E);
    }
    GRID_BAR();
    for (int rep = 0; rep < PROBE_THIN; ++rep) ph_act(a, 0, UP_TA, gt, NGT);
    GRID_BAR();
    {
        Gemm g{XN, (const bf16_t*)(ws + WS_WUP) + (size_t)UP_TA * 256 * DM, M, UP_TB * 256, DM}; StaticOrder S; S.init(M, UP_TB * 256, G, bid);
        pg8::EpiBf16 E{(bf16_t*)(ws + WS_U), UP_TB * 256};
        gemm_phase<pg8::EpiBf16, StaticOrder, true, true>(lds, g, S, E);
    }
    GRID_BAR();
    for (int rep = 0; rep < PROBE_THIN; ++rep) ph_act(a, UP_TA, UP_TB, gt, NGT);
    GRID_BAR();
    {
        Gemm g{(const bf16_t*)(ws + WS_ACT), (const bf16_t*)(ws + WS_WDN), M, DM, DFF}; StaticOrder S; S.init(M, DM, G, bid);
        pg8::EpiBf16 E{(bf16_t*)(ws + WS_Y), DM};
        gemm_phase<pg8::EpiBf16, StaticOrder, true, true>(lds, g, S, E);
    }
    GRID_BAR();
    ph_final(a, gw, NGW, lane);
}

extern "C" void kernel_launch(void* const* d_in, const int* in_sizes, int n_in, void* d_out, int out_size, void* d_ws, size_t ws_size, hipStream_t stream) {
    static int grid = 0;
    if (grid == 0) {
        if (n_in != 21 || in_sizes[0] != M * DM || out_size != M * DM || ws_size < WS_END) {
            fprintf(stderr, "kernel_launch: unexpected shapes (n_in %d, in0 %d, out %d, ws %zu; need ws >= %zu)\n", n_in, n_in > 0 ? in_sizes[0] : -1, out_size, ws_size, (size_t)WS_END); grid = -1; return; }
        int dev = 0, cus = 0, per_cu = 0;
        (void)hipGetDevice(&dev);
        (void)hipDeviceGetAttribute(&cus, hipDeviceAttributeMultiprocessorCount, dev);
        if (hipFuncSetAttribute((const void*)mega_fwd, hipFuncAttributeMaxDynamicSharedMemorySize, LDS_BYTES) != hipSuccess) { fprintf(stderr, "kernel_launch: hipFuncSetAttribute failed\n"); grid = -1; return; }
        if (hipOccupancyMaxActiveBlocksPerMultiprocessor(&per_cu, (const void*)mega_fwd, NTHREADS, LDS_BYTES) != hipSuccess || per_cu < 1) { fprintf(stderr, "kernel_launch: occupancy query failed (%d)\n", per_cu); (void)hipGetLastError(); per_cu = 1; }
        grid = cus * per_cu;
        fprintf(stderr, "kernel_launch: %d CUs x %d workgroups\n", cus, per_cu);
    }
    if (grid < 0) return;
    if (hipMemsetAsync((char*)d_ws + WS_BAR, 0, BAR_BYTES, stream) != hipSuccess) { fprintf(stderr, "kernel_launch: memset failed\n"); return; }
    Args a{};
    a.x = (const float*)d_in[0]; a.c = (const float*)d_in[1]; a.pos = (const int*)d_in[2]; a.w_ada = (const float*)d_in[3]; a.b_ada = (const float*)d_in[4];
    a.g_pre_mix = (const float*)d_in[5]; a.g_post_mix = (const float*)d_in[6]; a.w_in = (const float*)d_in[7]; a.g_q = (const float*)d_in[8]; a.w_uq = (const float*)d_in[9];
    a.g_kv = (const float*)d_in[10]; a.w_ukv = (const float*)d_in[11]; a.conv_w_mix = (const float*)d_in[12]; a.conv_b_mix = (const float*)d_in[13]; a.w_o = (const float*)d_in[14];
    a.g_pre_ffn = (const float*)d_in[15]; a.g_post_ffn = (const float*)d_in[16]; a.w_up = (const float*)d_in[17]; a.conv_w_ffn = (const float*)d_in[18]; a.conv_b_ffn = (const float*)d_in[19];
    a.w_down = (const float*)d_in[20]; a.out = (float*)d_out; a.ws = (unsigned char*)d_ws;
    void* args[] = {&a};
    hipError_t e = hipLaunchCooperativeKernel((const void*)mega_fwd, dim3(grid), dim3(NTHREADS), args, LDS_BYTES, stream);
    if (e != hipSuccess) fprintf(stderr, "kernel_launch: cooperative launch failed: %s (grid %d)\n", hipGetErrorString(e), grid);
}
```

```cpp
#include <hip/hip_runtime.h>
#include <hip/hip_cooperative_groups.h>
#include <cstdio>
#include <cstdint>
namespace cg = cooperative_groups;

constexpr int BATCH = 2, SEQ = 8192, DM = 2048, M = BATCH * SEQ;
constexpr int QL = 768, KVL = 512, ROPE = 64, CW = 1024, INC = 4416, INP = 4608;
constexpr int NH = 8, DQK = 192, NQ = NH * DQK  , NKV = NH * 256  ;
constexpr int DFF = 5632, NUP = 2 * DFF;
constexpr int NMODC = 6 * DM;
constexpr float RMS_EPS = 1e-6f;
constexpr int PC_Q = 0, PC_KV = 768, PC_GB = 1280, PC_GC = 2304, PC_CI = 3328, PC_KR = 4352;
constexpr int UP_TA = 20, UP_TB = 24;

constexpr size_t MiB = 1u << 20;
constexpr size_t WS_WUP = 0, WS_WDN = 44 * MiB, WS_MOD = 66 * MiB;
constexpr size_t WS_XN = 68 * MiB;
constexpr size_t WS_WIN = 132 * MiB, WS_WUQ = 150 * MiB, WS_WUKV = 153 * MiB, WS_WO = 155 * MiB, WS_CS = 163 * MiB;
constexpr size_t WS_PROJ = 168 * MiB;
constexpr size_t WS_QN = 312 * MiB, WS_KVN = 336 * MiB, WS_KR = 352 * MiB, WS_Q = 354 * MiB, WS_KV = 402 * MiB;
constexpr size_t WS_U = 132 * MiB;
constexpr size_t WS_ACT = 324 * MiB;
constexpr size_t WS_Y = 132 * MiB;
constexpr size_t WS_END = 500 * MiB;

#define LAS __attribute__((address_space(3)))
typedef unsigned u32x4 __attribute__((ext_vector_type(4)));
typedef unsigned u32x2 __attribute__((ext_vector_type(2)));
typedef float f32x2 __attribute__((ext_vector_type(2)));
typedef unsigned short bf16_t;
typedef short bf16x8 __attribute__((ext_vector_type(8)));
typedef short s16x4 __attribute__((ext_vector_type(4)));
typedef float f32x4 __attribute__((ext_vector_type(4)));
typedef float f32x16 __attribute__((ext_vector_type(16)));
namespace pg8 {
#define PG8_LAS __attribute__((address_space(3)))
typedef unsigned short bf16_t;
typedef short bf16x8 __attribute__((ext_vector_type(8)));
typedef float f32x4 __attribute__((ext_vector_type(4)));
typedef unsigned u32x4 __attribute__((ext_vector_type(4)));
constexpr int BM = 256, BK = 64, HALF = 128, HTB = HALF * BK * 2  , STAGE_BYTES = 8 * HTB, NXCD = 8, WGM = 8;

__host__ __device__ __forceinline__ int lds_byte(int r, int c) { const int st = (r >> 4) * 2 + (c >> 5), rr = r & 15, cc = c & 31, ob = rr * 64 + cc * 2; return st * 1024 + (ob ^ (((ob >> 9) & 1) << 5)); }
__host__ __device__ __forceinline__ void stage_rc(int b, int& R, int& C) { const int st = b / 1024, sb = b % 1024, swz = sb ^ (((sb >> 9) & 1) << 5); R = (st >> 1) * 16 + swz / 64; C = (st & 1) * 32 + (swz % 64) / 2; }
__host__ __device__ __forceinline__ int perm32(int rho) { const int n = rho >> 4, i = rho & 15; return 8 * (i >> 2) + 4 * n + (i & 3); }

struct Unit { int pm, pn; };
struct Gemm { const bf16_t* A; const bf16_t* Bt; int M, N, K; };

struct StaticOrder {
    int nM, nN, nwg, G, c;
    __host__ __device__ void init(int M, int N, int G_, int c_) { nM = M / BM; nN = N / BM; nwg = nM * nN; G = G_; c = c_; }
    __host__ __device__ bool next(int i, Unit& u) const {
        const long L = (long)i * G + c; if (L >= nwg) return false;
        int wgid = (int)L; { const int q = nwg / NXCD, r = nwg % NXCD, xcd = wgid % NXCD, off = wgid / NXCD; wgid = (xcd < r ? xcd * (q + 1) : r * (q + 1) + (xcd - r) * q) + off; }
        const int nig = WGM * nN, gid = wgid / nig, fm = gid * WGM, gsz = (nM - fm) < WGM ? (nM - fm) : WGM;
        u.pm = fm + ((wgid % nig) % gsz); u.pn = (wgid % nig) / gsz; return true;
    }
    __device__ __forceinline__ void a_ready(const Unit&) const {}
    __device__ __forceinline__ void done(const Unit&) const {}
};

__device__ __forceinline__ unsigned cvt_pk_bf16(float lo, float hi) { unsigned r; asm volatile("v_cvt_pk_bf16_f32 %0, %1, %2" : "=v"(r) : "v"(lo), "v"(hi)); return r; }
struct EpiBf16 {
    static constexpr bool PERM = true, AFTER_DRAIN = false;
    bf16_t* O; int ldc;
    __device__ __forceinline__ void operator()(const f32x4 (&acc)[2][2][4][2], const Unit& u, int wr, int wc, int fr, int fq) const {
        const int row0 = u.pm * BM + wr * 64 + fr, col0 = u.pn * BM + wc * 32 + 8 * fq;
#pragma unroll
        for (int ai = 0; ai < 2; ++ai)
#pragma unroll
            for (int m = 0; m < 4; ++m) { bf16_t* rowp = O + (size_t)(row0 + ai * HALF + m * 16) * ldc + col0;
#pragma unroll
                for (int bj = 0; bj < 2; ++bj) { const f32x4 v0 = acc[ai][bj][m][0], v1 = acc[ai][bj][m][1];
                    u32x4 w; w.x = cvt_pk_bf16(v0[0], v0[1]); w.y = cvt_pk_bf16(v0[2], v0[3]); w.z = cvt_pk_bf16(v1[0], v1[1]); w.w = cvt_pk_bf16(v1[2], v1[3]);
                    *(u32x4*)(rowp + bj * HALF) = w; } }
    }
};
struct EpiF32 {
    static constexpr bool PERM = true, AFTER_DRAIN = false;
    float* O; int ldc;
    __device__ __forceinline__ void operator()(const f32x4 (&acc)[2][2][4][2], const Unit& u, int wr, int wc, int fr, int fq) const {
        const int row0 = u.pm * BM + wr * 64 + fr, col0 = u.pn * BM + wc * 32 + 8 * fq;
#pragma unroll
        for (int ai = 0; ai < 2; ++ai)
#pragma unroll
            for (int m = 0; m < 4; ++m) { float* rowp = O + (size_t)(row0 + ai * HALF + m * 16) * ldc + col0;
#pragma unroll
                for (int bj = 0; bj < 2; ++bj) { *(f32x4*)(rowp + bj * HALF) = acc[ai][bj][m][0]; *(f32x4*)(rowp + bj * HALF + 4) = acc[ai][bj][m][1]; } }
    }
};
struct EpiQ {
    static constexpr bool PERM = true, AFTER_DRAIN = false;
    bf16_t* O; const float* CS;
    __device__ __forceinline__ void operator()(const f32x4 (&acc)[2][2][4][2], const Unit& u, int wr, int wc, int fr, int fq) const {
        const int row0 = u.pm * BM + wr * 64 + fr;
#pragma unroll
        for (int bj = 0; bj < 2; ++bj) {
            const int cb = u.pn * BM + bj * HALF + wc * 32, within = cb % 192; const bool rope = within >= 128;
            const int j0 = ((within - 128) >> 1) + 4 * fq;
#pragma unroll
            for (int ai = 0; ai < 2; ++ai)
#pragma unroll
                for (int m = 0; m < 4; ++m) { const int row = row0 + ai * HALF + m * 16;
                    f32x4 v0 = acc[ai][bj][m][0], v1 = acc[ai][bj][m][1];
                    if (rope) { const f32x4 c0 = *(const f32x4*)(CS + (size_t)row * 64 + j0 * 2), c1 = *(const f32x4*)(CS + (size_t)row * 64 + j0 * 2 + 4);
                        f32x4 a, b;
                        a[0] = v0[0] * c0[0] - v0[1] * c0[1]; a[1] = v0[1] * c0[0] + v0[0] * c0[1]; a[2] = v0[2] * c0[2] - v0[3] * c0[3]; a[3] = v0[3] * c0[2] + v0[2] * c0[3];
                        b[0] = v1[0] * c1[0] - v1[1] * c1[1]; b[1] = v1[1] * c1[0] + v1[0] * c1[1]; b[2] = v1[2] * c1[2] - v1[3] * c1[3]; b[3] = v1[3] * c1[2] + v1[2] * c1[3];
                        v0 = a; v1 = b; }
                    u32x4 w; w.x = cvt_pk_bf16(v0[0], v0[1]); w.y = cvt_pk_bf16(v0[2], v0[3]); w.z = cvt_pk_bf16(v1[0], v1[1]); w.w = cvt_pk_bf16(v1[2], v1[3]);
                    *(u32x4*)(O + (size_t)row * NQ + cb + 8 * fq) = w; }
        }
    }
};
template <class Epi, class Sched, bool ALIGN_EPI = false, bool SP2 = false>
__device__ __forceinline__ void gemm_phase(PG8_LAS unsigned char* lds, const Gemm g, const Sched& S, const Epi& E) {
    int tid_o = threadIdx.x; asm volatile("" : "+v"(tid_o)); const int tid = tid_o, wid = __builtin_amdgcn_readfirstlane(tid >> 6), lane = tid & 63, wr = wid >> 2, wc = wid & 3, fr = lane & 15, fq = lane >> 4;
    const int K = g.K, nt = K / BK;
    unsigned voffA[2], voffB[2];
#pragma unroll
    for (int i = 0; i < 2; ++i) { int R, C; stage_rc(tid * 16 + i * 8192, R, C); const int Rb = Epi::PERM ? ((R & ~31) + perm32(R & 31)) : R;
        voffA[i] = (unsigned)(R * K + C) * 2u; voffB[i] = (unsigned)(Rb * K + C) * 2u; }
    const size_t kstep = (size_t)(BK * 2);
    const size_t hstep = (size_t)HALF * K * 2;
    const size_t tstep = 2 * hstep;
    const unsigned ldsw = (unsigned)wid * 1024u;
    const int aoff = lds_byte(wr * 64 + fr, fq * 8), boff = lds_byte(wc * 32 + fr, fq * 8);
#define PG8_SA(b, h) (((b) * 2 + (h)) * HTB)
#define PG8_SB(b, h) ((4 + (b) * 2 + (h)) * HTB)
#define PG8_STAGE(bufoff, gbase, voff) do { _Pragma("unroll") for (int _i = 0; _i < 2; ++_i) \
        __builtin_amdgcn_global_load_lds((const unsigned*)((const char*)(gbase) + (voff)[_i]), (PG8_LAS unsigned*)(lds + (bufoff) + ldsw + _i * 8192), 16, 0, 0); } while (0)
#define PG8_LDA(dst, b, h) do { _Pragma("unroll") for (int m = 0; m < 4; ++m) _Pragma("unroll") for (int k = 0; k < 2; ++k) dst[m][k] = *(const PG8_LAS bf16x8*)(lds + PG8_SA(b, h) + aoff + m * 2048 + k * 1024); } while (0)
#define PG8_LDB(dst, b, h) do { _Pragma("unroll") for (int n = 0; n < 2; ++n) _Pragma("unroll") for (int k = 0; k < 2; ++k) dst[n][k] = *(const PG8_LAS bf16x8*)(lds + PG8_SB(b, h) + boff + n * 2048 + k * 1024); } while (0)
#define PG8_MMA(ai, bj, At, Bt) do { __builtin_amdgcn_s_setprio(1); _Pragma("unroll") for (int m = 0; m < 4; ++m) _Pragma("unroll") for (int n = 0; n < 2; ++n) _Pragma("unroll") for (int k = 0; k < 2; ++k) \
        acc[ai][bj][m][n] = __builtin_amdgcn_mfma_f32_16x16x32_bf16(Bt[n][k], At[m][k], acc[ai][bj][m][n], 0, 0, 0); __builtin_amdgcn_s_setprio(0); } while (0)
#define PG8_WAIT_V(n) asm volatile("s_waitcnt vmcnt(" #n ")" ::: "memory")
#define PG8_WAIT_L(n) asm volatile("s_waitcnt lgkmcnt(" #n ")" ::: "memory")
#define PG8_BAR __builtin_amdgcn_s_barrier()
#define PG8_SCHED __builtin_amdgcn_sched_barrier(0)
    Unit cur, nxt; int ui = 0;
    if (!S.next(0, cur)) return;
    f32x4 acc[2][2][4][2];
#pragma unroll
    for (int a = 0; a < 2; ++a)
#pragma unroll
        for (int b = 0; b < 2; ++b)
#pragma unroll
            for (int m = 0; m < 4; ++m)
#pragma unroll
                for (int n = 0; n < 2; ++n) acc[a][b][m][n] = (f32x4){0.f, 0.f, 0.f, 0.f};
    bf16x8 At[4][2], B0[2][2], B1[2][2];
    const char* cA = (const char*)g.A + (size_t)cur.pm * tstep; const char* cB = (const char*)g.Bt + (size_t)cur.pn * tstep;
    S.a_ready(cur);
    if constexpr (SP2) {
        PG8_STAGE(PG8_SB(0, 0), cB, voffB); PG8_STAGE(PG8_SB(0, 1), cB + hstep, voffB); PG8_STAGE(PG8_SA(0, 0), cA, voffA); PG8_STAGE(PG8_SA(0, 1), cA + hstep, voffA);
        if (wr == 1) PG8_BAR;
        PG8_WAIT_V(2); PG8_BAR;
        PG8_STAGE(PG8_SB(1, 0), cB + kstep, voffB); PG8_STAGE(PG8_SA(1, 0), cA + kstep, voffA); PG8_STAGE(PG8_SB(1, 1), cB + hstep + kstep, voffB);
        PG8_WAIT_V(6); PG8_BAR;
    } else {
        PG8_STAGE(PG8_SB(0, 0), cB, voffB); PG8_STAGE(PG8_SA(0, 0), cA, voffA); PG8_STAGE(PG8_SB(0, 1), cB + hstep, voffB); PG8_STAGE(PG8_SA(0, 1), cA + hstep, voffA);
        if (wr == 1) PG8_BAR;
        PG8_WAIT_V(4); PG8_BAR;
        PG8_STAGE(PG8_SB(1, 0), cB + kstep, voffB); PG8_STAGE(PG8_SA(1, 0), cA + kstep, voffA); PG8_STAGE(PG8_SB(1, 1), cB + hstep + kstep, voffB);
        PG8_WAIT_V(6); PG8_BAR;
    }
    for (;;) {
        const bool has_next = S.next(ui + 1, nxt);
        const char* nA = has_next ? (const char*)g.A + (size_t)nxt.pm * tstep : cA; const char* nB = has_next ? (const char*)g.Bt + (size_t)nxt.pn * tstep : cB;
        for (int t = 0; t < nt; t += 2) {
            const bool last = (t == nt - 2);
            const char* a1 = cA + (size_t)(t + 1) * kstep;
            const char* a2 = last ? nA : cA + (size_t)(t + 2) * kstep; const char* b2 = last ? nB : cB + (size_t)(t + 2) * kstep;
            const char* a3 = a2 + kstep; const char* b3 = b2 + kstep;
            if (last && has_next) S.a_ready(nxt);
            if constexpr (SP2) {
            PG8_LDB(B0, 0, 0); PG8_LDB(B1, 0, 1); PG8_SCHED; PG8_LDA(At, 0, 0); PG8_STAGE(PG8_SA(1, 1), a1 + hstep, voffA);
            PG8_WAIT_V(8); PG8_WAIT_L(0); PG8_BAR; PG8_MMA(0, 0, At, B0); PG8_MMA(0, 1, At, B1); PG8_BAR; PG8_SCHED;
            PG8_LDA(At, 0, 1); PG8_STAGE(PG8_SB(0, 0), b2, voffB); PG8_STAGE(PG8_SB(0, 1), b2 + hstep, voffB); PG8_STAGE(PG8_SA(0, 0), a2, voffA);
            PG8_WAIT_V(8); PG8_WAIT_L(0); PG8_BAR; PG8_MMA(1, 0, At, B0); PG8_MMA(1, 1, At, B1); PG8_BAR; PG8_SCHED;
            PG8_LDB(B0, 1, 0); PG8_LDB(B1, 1, 1); PG8_SCHED; PG8_LDA(At, 1, 0); PG8_STAGE(PG8_SA(0, 1), a2 + hstep, voffA);
            PG8_WAIT_V(8); PG8_WAIT_L(0); PG8_BAR; PG8_MMA(0, 0, At, B0); PG8_MMA(0, 1, At, B1); PG8_BAR; PG8_SCHED;
            PG8_LDA(At, 1, 1); PG8_STAGE(PG8_SB(1, 0), b3, voffB); PG8_STAGE(PG8_SB(1, 1), b3 + hstep, voffB); PG8_STAGE(PG8_SA(1, 0), a3, voffA);
            PG8_WAIT_V(8); PG8_WAIT_L(0); PG8_BAR; PG8_MMA(1, 0, At, B0); PG8_MMA(1, 1, At, B1); PG8_BAR; PG8_SCHED;
            } else {
            PG8_LDB(B0, 0, 0); PG8_SCHED; PG8_LDA(At, 0, 0); PG8_STAGE(PG8_SA(1, 1), a1 + hstep, voffA);
            PG8_WAIT_L(8); PG8_BAR; PG8_WAIT_L(0); PG8_MMA(0, 0, At, B0); PG8_BAR; PG8_SCHED;
            PG8_LDB(B1, 0, 1); PG8_STAGE(PG8_SB(0, 0), b2, voffB);
            PG8_BAR; PG8_WAIT_L(0); PG8_MMA(0, 1, At, B1); PG8_BAR;
            PG8_LDA(At, 0, 1); PG8_STAGE(PG8_SA(0, 0), a2, voffA);
            PG8_BAR; PG8_WAIT_L(0); PG8_MMA(1, 0, At, B0); PG8_BAR; PG8_SCHED;
            PG8_STAGE(PG8_SB(0, 1), b2 + hstep, voffB);
            PG8_WAIT_V(6); PG8_BAR; PG8_MMA(1, 1, At, B1); PG8_BAR;
            PG8_LDB(B0, 1, 0); PG8_SCHED; PG8_LDA(At, 1, 0); PG8_STAGE(PG8_SA(0, 1), a2 + hstep, voffA);
            PG8_WAIT_L(8); PG8_BAR; PG8_WAIT_L(0); PG8_MMA(0, 0, At, B0); PG8_BAR; PG8_SCHED;
            PG8_LDB(B1, 1, 1); PG8_STAGE(PG8_SB(1, 0), b3, voffB);
            PG8_BAR; PG8_WAIT_L(0); PG8_MMA(0, 1, At, B1); PG8_BAR;
            PG8_LDA(At, 1, 1); PG8_STAGE(PG8_SA(1, 0), a3, voffA);
            PG8_BAR; PG8_WAIT_L(0); PG8_MMA(1, 0, At, B0); PG8_BAR; PG8_SCHED;
            PG8_STAGE(PG8_SB(1, 1), b3 + hstep, voffB);
            PG8_WAIT_V(6); PG8_BAR; PG8_MMA(1, 1, At, B1); PG8_BAR;
            }
        }
        if constexpr (ALIGN_EPI) { if (wr == 0) PG8_BAR; }
        if constexpr (!Epi::AFTER_DRAIN) { E(acc, cur, wr, wc, fr, fq); S.done(cur); }
        if (!has_next) break;
#pragma unroll
        for (int a = 0; a < 2; ++a)
#pragma unroll
            for (int b = 0; b < 2; ++b)
#pragma unroll
                for (int m = 0; m < 4; ++m)
#pragma unroll
                    for (int n = 0; n < 2; ++n) acc[a][b][m][n] = (f32x4){0.f, 0.f, 0.f, 0.f};
        cur = nxt; cA = nA; cB = nB; ++ui;
        if constexpr (ALIGN_EPI) { if (wr == 1) PG8_BAR; }
    }
    PG8_WAIT_V(0);
    if constexpr (!ALIGN_EPI) { if (wr == 0) PG8_BAR; }
    PG8_BAR;
    if constexpr (Epi::AFTER_DRAIN) { E.fused(acc, cur, wr, wc, fr, fq, lds, wid, lane); S.done(cur); }
#undef PG8_SA
#undef PG8_SB
#undef PG8_STAGE
#undef PG8_LDA
#undef PG8_LDB
#undef PG8_MMA
#undef PG8_WAIT_V
#undef PG8_WAIT_L
#undef PG8_BAR
#undef PG8_SCHED
}
}
namespace att {
constexpr int NW = 8, QBLK = 32, KVBLK = 64, QB = NW * QBLK, DV = 128;
constexpr int KROW = 400;
constexpr int SHM_K = KVBLK * KROW, SHM_V = KVBLK * DV * 2;
constexpr int OFF_V = 0, OFF_K = 2 * SHM_V, OFF_WS = OFF_K + 2 * SHM_K, LDS_BYTES = OFF_WS + NW * 64 * 4;
constexpr float SCALE = 0.07216878364870322f;
constexpr float THR = 8.f;
#define SBAR() __builtin_amdgcn_sched_barrier(0)
__device__ __forceinline__ int v_st(int k, int c) { const int kk = (k & ~0xC) | ((k & 4) << 1) | ((k & 8) >> 1); return ((kk >> 3) * 4 + (c >> 5)) * 512 + ((kk & 7) * 32 + (c & 31)) * 2; }
__device__ __forceinline__ int v_rd_base(int lane) { return ((lane & 3) << 3) | (((lane >> 2) & 3) << 6) | (((lane >> 4) & 1) << 5) | (((lane >> 5) & 1) << 8); }
constexpr int v_rd_off(int d0, int ks, int half) { return d0 * 512 + ks * 4096 + half * 2048; }
__device__ __forceinline__ int crow(int r, int hi) { return (r & 3) + 8 * (r >> 2) + 4 * hi; }
__device__ __forceinline__ unsigned cvtpk(float lo, float hi) { unsigned r; asm volatile("v_cvt_pk_bf16_f32 %0, %1, %2" : "=v"(r) : "v"(lo), "v"(hi)); return r; }
__device__ __forceinline__ void mask_tile(f32x16& p0, f32x16& p1, int dq) {
    const float NEG = -__builtin_inff();
#pragma unroll
    for (int r = 0; r < 16; ++r) { const int c = (r & 3) + 8 * (r >> 2);
        if (dq - c < 0) p0[r] = NEG;
        if (dq - c - 32 < 0) p1[r] = NEG; }
}
__device__ __forceinline__ void partialSM(f32x16& p0, f32x16& p1, float& m_reg, float& mn, float& alpha) {
    float pmax = p0[0];
#pragma unroll
    for (int r = 1; r < 16; ++r) pmax = fmaxf(pmax, p0[r]);
#pragma unroll
    for (int r = 0; r < 16; ++r) pmax = fmaxf(pmax, p1[r]);
    { auto rr = __builtin_amdgcn_permlane32_swap(__float_as_uint(pmax), __float_as_uint(pmax), false, false);
      pmax = fmaxf(__uint_as_float(rr[0]), __uint_as_float(rr[1])); }
    constexpr float C2 = 1.4426950408889634f * SCALE;
    if (__builtin_expect(__all((pmax - m_reg) * SCALE <= THR), 1)) { mn = m_reg; alpha = 1.f; }
    else { mn = fmaxf(m_reg, pmax); alpha = __builtin_amdgcn_exp2f((m_reg - mn) * C2); m_reg = mn; }
    const float mnL = -mn * C2;
#pragma unroll
    for (int r = 0; r < 16; ++r) p0[r] = fmaf(p0[r], C2, mnL);
#pragma unroll
    for (int r = 0; r < 16; ++r) p1[r] = fmaf(p1[r], C2, mnL);
#pragma unroll
    for (int r = 0; r < 16; ++r) p0[r] = __builtin_amdgcn_exp2f(p0[r]);
}
__device__ __forceinline__ void finishSM(f32x16& p0, f32x16& p1, float alpha, float& l_reg, bf16x8& pa0, bf16x8& pa1, bf16x8& pa2, bf16x8& pa3) {
#pragma unroll
    for (int r = 0; r < 16; ++r) p1[r] = __builtin_amdgcn_exp2f(p1[r]);
    float ps = 0;
#pragma unroll
    for (int r = 0; r < 16; ++r) ps += p0[r];
#pragma unroll
    for (int r = 0; r < 16; ++r) ps += p1[r];
    { auto rr = __builtin_amdgcn_permlane32_swap(__float_as_uint(ps), __float_as_uint(ps), false, false);
      ps = __uint_as_float(rr[0]) + __uint_as_float(rr[1]); }
    l_reg = l_reg * alpha + ps;
#define PK4(P, B_, OUT) do { unsigned a0 = cvtpk(P[B_+0], P[B_+1]), a1 = cvtpk(P[B_+2], P[B_+3]);                          \
        unsigned b0 = cvtpk(P[B_+4], P[B_+5]), b1 = cvtpk(P[B_+6], P[B_+7]);                                             \
        auto r0 = __builtin_amdgcn_permlane32_swap(a0, b0, false, false); auto r1 = __builtin_amdgcn_permlane32_swap(a1, b1, false, false); \
        u32x4 w = {r0[0], r1[0], r0[1], r1[1]}; OUT = *reinterpret_cast<bf16x8*>(&w); } while (0)
    PK4(p0, 0, pa0); PK4(p0, 8, pa1); PK4(p1, 0, pa2); PK4(p1, 8, pa3);
#undef PK4
}
__device__ __forceinline__ void qkt(f32x16& p0, f32x16& p1, const char* Kb, int r32, int hi, const bf16x8* qr) {
    p0 = f32x16{}; p1 = f32x16{};
    const char* a = Kb + r32 * KROW + hi * 16;
#pragma unroll
    for (int d0 = 0; d0 < 12; ++d0) {
        const bf16x8 b0 = *reinterpret_cast<const bf16x8*>(a + d0 * 32);
        const bf16x8 b1 = *reinterpret_cast<const bf16x8*>(a + d0 * 32 + 32 * KROW);
        p0 = __builtin_amdgcn_mfma_f32_32x32x16_bf16(b0, qr[d0], p0, 0, 0, 0);
        p1 = __builtin_amdgcn_mfma_f32_32x32x16_bf16(b1, qr[d0], p1, 0, 0, 0); }
}
__device__ __forceinline__ void pv_tile(f32x16* o, int vb0, bf16x8 pa0, bf16x8 pa1, bf16x8 pa2, bf16x8 pa3) {
#define TRRD(dst, off) asm volatile("ds_read_b64_tr_b16 %0, %1 offset:%2" : "=&v"(dst) : "v"(vb0), "i"(off) : "memory")
#define PV_D0(d0) do { s16x4 l0, l1, l2, l3, h0, h1, h2, h3; constexpr int b_ = v_rd_off(d0, 0, 0); \
        TRRD(l0, b_); TRRD(h0, b_ + 2048); TRRD(l1, b_ + 4096); TRRD(h1, b_ + 6144); TRRD(l2, b_ + 8192); TRRD(h2, b_ + 10240); TRRD(l3, b_ + 12288); TRRD(h3, b_ + 14336); \
        asm volatile("s_waitcnt lgkmcnt(0)" ::: "memory"); SBAR();   \
        o[d0] = __builtin_amdgcn_mfma_f32_32x32x16_bf16(pa0, (bf16x8){l0[0], l0[1], l0[2], l0[3], h0[0], h0[1], h0[2], h0[3]}, o[d0], 0, 0, 0);   \
        o[d0] = __builtin_amdgcn_mfma_f32_32x32x16_bf16(pa1, (bf16x8){l1[0], l1[1], l1[2], l1[3], h1[0], h1[1], h1[2], h1[3]}, o[d0], 0, 0, 0);   \
        o[d0] = __builtin_amdgcn_mfma_f32_32x32x16_bf16(pa2, (bf16x8){l2[0], l2[1], l2[2], l2[3], h2[0], h2[1], h2[2], h2[3]}, o[d0], 0, 0, 0);   \
        o[d0] = __builtin_amdgcn_mfma_f32_32x32x16_bf16(pa3, (bf16x8){l3[0], l3[1], l3[2], l3[3], h3[0], h3[1], h3[2], h3[3]}, o[d0], 0, 0, 0); } while (0)
    PV_D0(0); PV_D0(1); PV_D0(2); PV_D0(3);
#undef PV_D0
#undef TRRD
}
__device__ __forceinline__ void attn_unit(int b, int h, int qb, const bf16_t* __restrict__ Q, const bf16_t* __restrict__ KVp, const bf16_t* __restrict__ KR, bf16_t* __restrict__ O, char* lds) {
    int tid_o = threadIdx.x; asm volatile("" : "+v"(tid_o)); const int tid = tid_o, wid = __builtin_amdgcn_readfirstlane(tid >> 6), lane = tid & 63, r32 = lane & 31, hi = lane >> 5;
    const size_t rowbase = (size_t)b * SEQ; const int q0 = qb * QB;
    char* V_lds = lds + OFF_V; char* K_lds = lds + OFF_K;
    float* ws = (float*)(lds + OFF_WS) + wid * 64; float* li_l = ws; float* al_l = ws + 32;
    bf16x8 qr[12];
    { const bf16_t* Qw = Q + (rowbase + q0 + wid * QBLK + r32) * NQ + h * DQK + hi * 8;
#pragma unroll
      for (int d0 = 0; d0 < 12; ++d0) qr[d0] = *reinterpret_cast<const bf16x8*>(Qw + d0 * 16); }
    const bf16_t* ksrc[3]; int kstr[3], kdst[3];
#pragma unroll
    for (int i = 0; i < 3; ++i) { const int c = tid + 512 * i, kr = c / 24, kc = c - kr * 24;
        if (kc < 16) { ksrc[i] = KVp + (rowbase + kr) * NKV + h * 256 + kc * 8; kstr[i] = KVBLK * NKV; }
        else { ksrc[i] = KR + (rowbase + kr) * 64 + (kc - 16) * 8; kstr[i] = KVBLK * 64; }
        kdst[i] = kr * KROW + kc * 16; }
    const int sr = tid >> 4, sc = (tid & 15) * 8;
    const bf16_t* vsrc = KVp + (rowbase + sr) * NKV + h * 256 + 128 + sc;
    const int vst0 = v_st(sr, sc), vst1 = v_st(32 + sr, sc);
    const int vb0 = (int)(uintptr_t)V_lds + v_rd_base(lane);
    const int NT = 4 * qb + 4;
    const int qlo = q0 + wid * QBLK, qm = qlo + r32 - 4 * hi;
    bf16x8 sk0, sk1, sk2, sv0, sv1;
#define SLOAD(t) do { sk0 = *reinterpret_cast<const bf16x8*>(ksrc[0] + (size_t)(t) * kstr[0]); sk1 = *reinterpret_cast<const bf16x8*>(ksrc[1] + (size_t)(t) * kstr[1]); \
        sk2 = *reinterpret_cast<const bf16x8*>(ksrc[2] + (size_t)(t) * kstr[2]); \
        sv0 = *reinterpret_cast<const bf16x8*>(vsrc + (size_t)(t) * KVBLK * NKV); sv1 = *reinterpret_cast<const bf16x8*>(vsrc + (size_t)(t) * KVBLK * NKV + 32 * NKV); } while (0)
#define SWRITE(bf) do { *reinterpret_cast<bf16x8*>(K_lds + (bf) * SHM_K + kdst[0]) = sk0; *reinterpret_cast<bf16x8*>(K_lds + (bf) * SHM_K + kdst[1]) = sk1; \
        *reinterpret_cast<bf16x8*>(K_lds + (bf) * SHM_K + kdst[2]) = sk2; \
        *reinterpret_cast<bf16x8*>(V_lds + (bf) * SHM_V + vst0) = sv0; *reinterpret_cast<bf16x8*>(V_lds + (bf) * SHM_V + vst1) = sv1; } while (0)
    SLOAD(0); SWRITE(0); __syncthreads();
    float m_reg = -1e30f, l_reg = 0.f; f32x16 o[4];
#pragma unroll
    for (int d = 0; d < 4; ++d) o[d] = f32x16{};
    for (int t = 0; t < NT; ++t) {
        const int cur = t & 1;
        if (t + 1 < NT) { SLOAD(t + 1); } SBAR();
        f32x16 p0, p1; float mn, alpha; bf16x8 pa0, pa1, pa2, pa3;
        qkt(p0, p1, K_lds + cur * SHM_K, r32, hi, qr);
        const int kb = t * KVBLK;
        if (kb + KVBLK - 1 > qlo) mask_tile(p0, p1, qm - kb);
        partialSM(p0, p1, m_reg, mn, alpha);
        if (__any(alpha < 1.f)) { if (hi == 0) al_l[r32] = alpha; asm volatile("s_waitcnt lgkmcnt(0)" ::: "memory");
#pragma unroll
            for (int d_ = 0; d_ < 4; ++d_)
#pragma unroll
                for (int r = 0; r < 16; ++r) o[d_][r] *= al_l[crow(r, hi)]; }
        finishSM(p0, p1, alpha, l_reg, pa0, pa1, pa2, pa3); SBAR();
        pv_tile(o, vb0 + cur * SHM_V, pa0, pa1, pa2, pa3);
        if (t + 1 < NT) { SWRITE(cur ^ 1); }
        __syncthreads();
    }
    if (hi == 0) li_l[r32] = l_reg; asm volatile("s_waitcnt lgkmcnt(0)" ::: "memory");
    float rli[16];
#pragma unroll
    for (int r = 0; r < 16; ++r) rli[r] = __builtin_amdgcn_rcpf(li_l[crow(r, hi)]);
    bf16_t* Ow = O + (rowbase + q0 + wid * QBLK) * DM + h * DV;
#pragma unroll
    for (int r = 0; r < 16; ++r) { const int orow = crow(r, hi);
#pragma unroll
        for (int d0 = 0; d0 < 4; ++d0) { const float v = o[d0][r] * rli[r]; const float vn = __shfl_xor(v, 1);
            if ((r32 & 1) == 0) *(unsigned*)(Ow + (size_t)orow * DM + d0 * 32 + r32) = cvtpk(v, vn); } }
    __syncthreads();
#undef SLOAD
#undef SWRITE
}
#undef SBAR
}
#define XB_TMO      128
#define XB_XCNT(j)  (256  + 64 * (j))
#define XB_XSUB(j)  (1280 + 64 * (j))
#define XB_XGEN(j)  (2304 + 64 * (j))
#define XB_TOP      3328
#define XB_TOPGEN   3392
#define XCD_BAR_WORDS 3456
#define XB_SPIN_CAP (1u << 18)

__device__ __forceinline__ unsigned xb_ld(unsigned* p)              { return __hip_atomic_load(p, __ATOMIC_RELAXED, __HIP_MEMORY_SCOPE_AGENT); }
__device__ __forceinline__ unsigned xb_add(unsigned* p, unsigned v) { return __hip_atomic_fetch_add(p, v, __ATOMIC_RELAXED, __HIP_MEMORY_SCOPE_AGENT); }
__device__ __forceinline__ unsigned xb_xcc_id() { return (unsigned)__builtin_amdgcn_s_getreg((3 << 11) | 20) & 0xFu; }
#define XB_SPIN(cond, bar) do { unsigned _sp = 0; while (cond) { __builtin_amdgcn_s_sleep(1); \
    if ((++_sp & 255u) == 0u) { if (xb_ld(&(bar)[XB_TMO])) break; if (_sp > XB_SPIN_CAP) { atomicAdd(&(bar)[XB_TMO], 1u); break; } } } } while (0)

struct XcdBarrier {
    unsigned* bar; unsigned x;
    volatile LAS unsigned* st;
};

__device__ __forceinline__ XcdBarrier xcd_barrier_post(unsigned* bar, volatile LAS unsigned* st) {
    XcdBarrier b; b.bar = bar; b.x = xb_xcc_id(); b.st = st;
    if (threadIdx.x == 0) (void)xb_add(&bar[XB_XCNT(b.x)], 1u);
    return b;
}
__device__ __forceinline__ void xcd_barrier_complete(unsigned* bar, unsigned x, unsigned& nloc, unsigned& nx) {
    const unsigned G = gridDim.x * gridDim.y * gridDim.z;
    unsigned sum, cnt, mine, sp = 0u;
    for (;;) {
        sum = 0u; cnt = 0u; mine = 0u;
#pragma unroll
        for (unsigned j = 0; j < 16; ++j) { const unsigned c = xb_ld(&bar[XB_XCNT(j)]); sum += c; cnt += (c > 0u) ? 1u : 0u; mine = (j == x) ? c : mine; }
        if (sum == G) break;
        __builtin_amdgcn_s_sleep(1);
        if ((++sp & 255u) == 0u) { if (xb_ld(&bar[XB_TMO])) break; if (sp > XB_SPIN_CAP) { atomicAdd(&bar[XB_TMO], 1u); break; } }
    }
    nloc = mine > 0u ? mine : 1u; nx = cnt > 0u ? cnt : 1u;
}

__device__ __forceinline__ void xcd_barrier(const XcdBarrier& b) {
    asm volatile("s_waitcnt vmcnt(0)" ::: "memory");
    __syncthreads();
    if (threadIdx.x == 0) {
        unsigned* bar = b.bar;
        __builtin_amdgcn_s_waitcnt(0);
        unsigned nloc = b.st[0], nx = b.st[1];
        if (nloc == 0u) { xcd_barrier_complete(bar, b.x, nloc, nx); b.st[0] = nloc; b.st[1] = nx; }
        const unsigned old = xb_add(&bar[XB_XSUB(b.x)], 1u);
        const unsigned gen = old / nloc;
        if (old + 1u == (gen + 1u) * nloc) {
            __builtin_amdgcn_fence(__ATOMIC_RELEASE, "agent");
            asm volatile("s_waitcnt vmcnt(0)" ::: "memory");
            const unsigned og = xb_add(&bar[XB_TOP], 1u);
            const unsigned tg = og / nx;
            if (og + 1u == (tg + 1u) * nx) xb_add(&bar[XB_TOPGEN], 1u);
            else XB_SPIN(xb_ld(&bar[XB_TOPGEN]) == tg, bar);
            __builtin_amdgcn_fence(__ATOMIC_ACQUIRE, "agent");
            xb_add(&bar[XB_XGEN(b.x)], 1u);
            asm volatile("s_waitcnt vmcnt(0)" ::: "memory");
        } else {
            XB_SPIN(xb_ld(&bar[XB_XGEN(b.x)]) == gen, bar);
            __builtin_amdgcn_fence(__ATOMIC_ACQUIRE, "agent");
            asm volatile("s_waitcnt vmcnt(0)" ::: "memory");
        }
    }
    __syncthreads();
}
using pg8::Gemm; using pg8::StaticOrder; using pg8::gemm_phase;
#define LDS_WAIT() asm volatile("s_waitcnt lgkmcnt(0)" ::: "memory")
constexpr int NWAVES = 8, NTHREADS = 512;
constexpr int LDS_BYTES = 135168;

__device__ __forceinline__ float wave_sum(float v) {
#pragma unroll
    for (int o = 1; o < 64; o <<= 1) v += __shfl_xor(v, o);
    return v;
}
__device__ __forceinline__ unsigned pk2(float lo, float hi) { return pg8::cvt_pk_bf16(lo, hi); }
__device__ __forceinline__ float bflo(unsigned u) { return __uint_as_float(u << 16); }
__device__ __forceinline__ float bfhi(unsigned u) { return __uint_as_float(u & 0xffff0000u); }
__device__ __forceinline__ void unpack8(const u32x4 w, float* f) { f[0] = bflo(w.x); f[1] = bfhi(w.x); f[2] = bflo(w.y); f[3] = bfhi(w.y); f[4] = bflo(w.z); f[5] = bfhi(w.z); f[6] = bflo(w.w); f[7] = bfhi(w.w); }
__device__ __forceinline__ u32x4 pack8f(const float* f) { u32x4 w; w.x = pk2(f[0], f[1]); w.y = pk2(f[2], f[3]); w.z = pk2(f[4], f[5]); w.w = pk2(f[6], f[7]); return w; }

template <int MAP> __device__ __forceinline__ int wmap(int n) {
    if (MAP == 1) { return n < 1280 ? n : (n < 1344 ? n + (PC_KR - 1280) : n - 64); }
    if (MAP == 2) { const int h = n / 192, w = n - h * 192; if (w < 128) return n; const int j = w - 128;
                    return h * 192 + 128 + (j < 32 ? 2 * j : 2 * (j - 32) + 1); }
    if (MAP == 3) { if (n < DFF) return (n >> 7) * 256 + (n & 127); const int n2 = n - DFF; return (n2 >> 7) * 256 + 128 + (n2 & 127); }
    return n;
}
template <int MAP> __device__ __forceinline__ void transpose_item(const float* __restrict__ W, int K, int N, bf16_t* __restrict__ WT, LAS float* scr, int item, int lane) {
    const int nblk = N / 32, kb = item / nblk, nb = item - kb * nblk, k0 = 64 * kb, n0 = 32 * nb;
    { const int lr = lane >> 3, lc = (lane & 7) * 4; f32x4 v[8];
#pragma unroll
      for (int i = 0; i < 8; ++i) v[i] = *(const f32x4*)(W + (size_t)(k0 + i * 8 + lr) * N + n0 + lc);
#pragma unroll
      for (int i = 0; i < 8; ++i) { LAS float* sp = scr + (i * 8 + lr) * 33 + lc; sp[0] = v[i][0]; sp[1] = v[i][1]; sp[2] = v[i][2]; sp[3] = v[i][3]; } }
    LDS_WAIT(); asm volatile("" ::: "memory");
    const int c = lane & 7;
#pragma unroll
    for (int j = 0; j < 4; ++j) { const int n = (lane >> 3) + 8 * j; const LAS float* s = scr + (8 * c) * 33 + n;
        u32x4 o; o.x = pk2(s[0 * 33], s[1 * 33]); o.y = pk2(s[2 * 33], s[3 * 33]); o.z = pk2(s[4 * 33], s[5 * 33]); o.w = pk2(s[6 * 33], s[7 * 33]);
        *(u32x4*)(WT + (size_t)wmap<MAP>(n0 + n) * K + k0 + 8 * c) = o; }
    LDS_WAIT(); asm volatile("" ::: "memory");
}

struct Args {
    const float* x; const float* c; const int* pos; const float* w_ada; const float* b_ada; const float* g_pre_mix; const float* g_post_mix;
    const float* w_in; const float* g_q; const float* w_uq; const float* g_kv; const float* w_ukv; const float* conv_w_mix; const float* conv_b_mix;
    const float* w_o; const float* g_pre_ffn; const float* g_post_ffn; const float* w_up; const float* conv_w_ffn; const float* conv_b_ffn; const float* w_down;
    float* out; unsigned char* ws;
};

__device__ __forceinline__ void ph_prologue(const Args& a, LAS unsigned char* lds, int G) {
    int tid_o = threadIdx.x; asm volatile("" : "+v"(tid_o)); const int tid = tid_o, lane = tid & 63, wave = tid >> 6;
    unsigned char* ws = a.ws;
    float* MOD = (float*)(ws + WS_MOD);
    for (int it = blockIdx.x; it < NMODC / 64; it += G) {
        LAS float* red = (LAS float*)lds;
        const int kg = tid >> 4, l16 = tid & 15, col = it * 64 + l16 * 4;
        f32x4 a0 = {0.f, 0.f, 0.f, 0.f}, a1 = {0.f, 0.f, 0.f, 0.f};
#pragma unroll 8
        for (int i = 0; i < 64; ++i) { const int k = kg + 32 * i;
            const f32x4 w = *(const f32x4*)(a.w_ada + (size_t)k * NMODC + col);
            const float c0 = a.c[k], c1 = a.c[DM + k];
            const float s0 = c0 / (1.f + __expf(-c0)), s1 = c1 / (1.f + __expf(-c1));
            a0 += w * s0; a1 += w * s1; }
        LAS float* rp = red + (kg * 16 + l16) * 8;
        rp[0] = a0[0]; rp[1] = a0[1]; rp[2] = a0[2]; rp[3] = a0[3]; rp[4] = a1[0]; rp[5] = a1[1]; rp[6] = a1[2]; rp[7] = a1[3];
        __syncthreads();
        if (tid < 128) { const int b = tid >> 6, cc = tid & 63; float s = 0.f;
            for (int g = 0; g < 32; ++g) s += red[(g * 16 + (cc >> 2)) * 8 + b * 4 + (cc & 3)];
            MOD[b * NMODC + it * 64 + cc] = s + a.b_ada[it * 64 + cc]; }
        __syncthreads();
    }
    LAS float* scr = (LAS float*)(lds + wave * 16384);
    const int gw = blockIdx.x * NWAVES + wave, NGW = G * NWAVES;
    bf16_t* WinT = (bf16_t*)(ws + WS_WIN); bf16_t* WuqT = (bf16_t*)(ws + WS_WUQ); bf16_t* WukvT = (bf16_t*)(ws + WS_WUKV);
    bf16_t* WoT = (bf16_t*)(ws + WS_WO); bf16_t* WupT = (bf16_t*)(ws + WS_WUP); bf16_t* WdnT = (bf16_t*)(ws + WS_WDN);
    constexpr int I_IN = (DM / 64) * (INC / 32), I_UQ = (QL / 64) * (NQ / 32), I_UKV = (KVL / 64) * (NKV / 32), I_O = (DM / 64) * (DM / 32), I_UP = (DM / 64) * (NUP / 32), I_DN = (DFF / 64) * (DM / 32);
    constexpr int I_UPD = I_UP / 3;
    constexpr int NITEMS = I_IN + I_UQ + I_UKV + I_O + (I_UP - I_UPD);
    for (int it = gw; it < NITEMS; it += NGW) {
        int r = it;
        if (r < I_UP - I_UPD) { transpose_item<3>(a.w_up, DM, NUP, WupT, scr, r + I_UPD, lane); continue; } r -= I_UP - I_UPD;
        if (r < I_IN) { transpose_item<1>(a.w_in, DM, INC, WinT, scr, r, lane); continue; } r -= I_IN;
        if (r < I_O) { transpose_item<0>(a.w_o, DM, DM, WoT, scr, r, lane); continue; } r -= I_O;
        if (r < I_UQ) { transpose_item<2>(a.w_uq, QL, NQ, WuqT, scr, r, lane); continue; } r -= I_UQ;
        transpose_item<0>(a.w_ukv, KVL, NKV, WukvT, scr, r, lane);
    }
    const int gt = blockIdx.x * NTHREADS + tid, NGT = G * NTHREADS;
    { u32x4* z = (u32x4*)(WinT + (size_t)INC * DM); const int nz = (INP - INC) * DM / 8;
      for (int i = gt; i < nz; i += NGT) z[i] = (u32x4){0u, 0u, 0u, 0u}; }
    { f32x2* CS = (f32x2*)(ws + WS_CS);
      for (int i = gt; i < M * 32; i += NGT) { const int row = i >> 5, j = i & 31;
          const float inv = 1.0f / exp2f((float)(2 * j) * (13.287712379549449f / 64.f));
          const float ang = (float)a.pos[row] * inv;
          const double rv = (double)ang * 0.15915494309189535; const float f = (float)(rv - __builtin_rint(rv));
          CS[i] = (f32x2){__builtin_amdgcn_cosf(f), __builtin_amdgcn_sinf(f)}; } }
}

__device__ __forceinline__ void ph_deferred(const Args& a, LAS unsigned char* lds, int rank, int n) {
    int tid_o = threadIdx.x; asm volatile("" : "+v"(tid_o)); const int tid = tid_o, lane = tid & 63, wave = tid >> 6;
    LAS float* scr = (LAS float*)(lds + wave * 16384);
    bf16_t* WupT = (bf16_t*)(a.ws + WS_WUP); bf16_t* WdnT = (bf16_t*)(a.ws + WS_WDN);
    constexpr int I_UP = (DM / 64) * (NUP / 32), I_DN = (DFF / 64) * (DM / 32), I_UPD = I_UP / 3;
    for (int it = rank * NWAVES + wave; it < I_DN + I_UPD; it += n * NWAVES) {
        if (it < I_DN) transpose_item<0>(a.w_down, DFF, DM, WdnT, scr, it, lane);
        else transpose_item<3>(a.w_up, DM, NUP, WupT, scr, it - I_DN, lane);
    }
}

__device__ __forceinline__ void ph_prenorm(const float* __restrict__ x, const float* __restrict__ g, const float* __restrict__ mod, int sh_i, int sc_i, bf16_t* __restrict__ XN, int gw, int NGW, int lane) {
    for (int row0 = gw; row0 < M; row0 += 2 * NGW) {
        int rows[2]; rows[0] = row0; rows[1] = row0 + NGW < M ? row0 + NGW : row0;
        f32x4 v[2][8];
#pragma unroll
        for (int q = 0; q < 2; ++q) { const f32x4* xr = (const f32x4*)(x + (size_t)rows[q] * DM) + lane;
#pragma unroll
            for (int j = 0; j < 8; ++j) v[q][j] = xr[64 * j]; }
#pragma unroll
        for (int q = 0; q < 2; ++q) { const int row = rows[q]; const float* mb = mod + (row >= SEQ ? NMODC : 0); float ss = 0.f;
#pragma unroll
            for (int j = 0; j < 8; ++j) ss += (v[q][j][0] * v[q][j][0] + v[q][j][1] * v[q][j][1]) + (v[q][j][2] * v[q][j][2] + v[q][j][3] * v[q][j][3]);
            const float rstd = rsqrtf(wave_sum(ss) * (1.f / DM) + RMS_EPS);
#pragma unroll
            for (int j = 0; j < 8; ++j) { const int e = (lane + 64 * j) * 4;
                const f32x4 g4 = *(const f32x4*)(g + e), s4 = *(const f32x4*)(mb + sc_i * DM + e), h4 = *(const f32x4*)(mb + sh_i * DM + e);
                const f32x4 o = v[q][j] * rstd * g4 * (s4 + 1.f) + h4;
                *(u32x2*)(XN + (size_t)row * DM + e) = (u32x2){pk2(o[0], o[1]), pk2(o[2], o[3])}; } }
    }
}

__device__ __forceinline__ void ph_mid(const Args& a, int gw, int NGW, int lane) {
    unsigned char* ws = a.ws;
    const bf16_t* PROJ = (const bf16_t*)(ws + WS_PROJ); const float* CS = (const float*)(ws + WS_CS);
    bf16_t* QN = (bf16_t*)(ws + WS_QN); bf16_t* KVN = (bf16_t*)(ws + WS_KVN); bf16_t* KR = (bf16_t*)(ws + WS_KR); bf16_t* MIXIN = (bf16_t*)(ws + WS_XN);
    for (int row = gw; row < M; row += NGW) {
        const bf16_t* pr = PROJ + (size_t)row * INP;
        {
            float f[3][4]; float ss = 0.f;
#pragma unroll
            for (int j = 0; j < 3; ++j) { const u32x2 w = *(const u32x2*)(pr + PC_Q + (lane + 64 * j) * 4);
                f[j][0] = bflo(w.x); f[j][1] = bfhi(w.x); f[j][2] = bflo(w.y); f[j][3] = bfhi(w.y);
                ss += (f[j][0] * f[j][0] + f[j][1] * f[j][1]) + (f[j][2] * f[j][2] + f[j][3] * f[j][3]); }
            const float rstd = rsqrtf(wave_sum(ss) * (1.f / QL) + RMS_EPS);
#pragma unroll
            for (int j = 0; j < 3; ++j) { const int e = (lane + 64 * j) * 4; const f32x4 g4 = *(const f32x4*)(a.g_q + e);
                *(u32x2*)(QN + (size_t)row * QL + e) = (u32x2){pk2(f[j][0] * rstd * g4[0], f[j][1] * rstd * g4[1]), pk2(f[j][2] * rstd * g4[2], f[j][3] * rstd * g4[3])}; }
        }
        {
            float f[8]; unpack8(*(const u32x4*)(pr + PC_KV + lane * 8), f); float ss = 0.f;
#pragma unroll
            for (int i = 0; i < 8; ++i) ss += f[i] * f[i];
            const float rstd = rsqrtf(wave_sum(ss) * (1.f / KVL) + RMS_EPS);
            const f32x4 g0 = *(const f32x4*)(a.g_kv + lane * 8), g1 = *(const f32x4*)(a.g_kv + lane * 8 + 4);
#pragma unroll
            for (int i = 0; i < 4; ++i) { f[i] *= rstd * g0[i]; f[4 + i] *= rstd * g1[i]; }
            *(u32x4*)(KVN + (size_t)row * KVL + lane * 8) = pack8f(f);
        }
        if (lane < 32) {
            const float x1 = __uint_as_float((unsigned)pr[PC_KR + lane] << 16), x2 = __uint_as_float((unsigned)pr[PC_KR + 32 + lane] << 16);
            const f32x2 cs = *(const f32x2*)(CS + (size_t)row * 64 + 2 * lane);
            *(unsigned*)(KR + (size_t)row * 64 + 2 * lane) = pk2(x1 * cs.x - x2 * cs.y, x2 * cs.x + x1 * cs.y);
        }
        const int tt = row & (SEQ - 1);
#pragma unroll
        for (int j = 0; j < 2; ++j) {
            const int c0 = lane * 8 + 512 * j;
            float gb[8], p0[8], p1[8], p2[8], t0[8], t1[8];
            unpack8(*(const u32x4*)(pr + PC_GB + c0), gb);
            unpack8(*(const u32x4*)(pr + PC_GC + c0), t0); unpack8(*(const u32x4*)(pr + PC_CI + c0), t1);
#pragma unroll
            for (int i = 0; i < 8; ++i) p0[i] = t0[i] * t1[i];
            const bf16_t* pr1 = pr - (tt >= 1 ? INP : 0); const bf16_t* pr2 = pr - (tt >= 2 ? 2 * INP : 0);
            const float m1 = tt >= 1 ? 1.f : 0.f, m2 = tt >= 2 ? 1.f : 0.f;
            unpack8(*(const u32x4*)(pr1 + PC_GC + c0), t0); unpack8(*(const u32x4*)(pr1 + PC_CI + c0), t1);
#pragma unroll
            for (int i = 0; i < 8; ++i) p1[i] = m1 * t0[i] * t1[i];
            unpack8(*(const u32x4*)(pr2 + PC_GC + c0), t0); unpack8(*(const u32x4*)(pr2 + PC_CI + c0), t1);
#pragma unroll
            for (int i = 0; i < 8; ++i) p2[i] = m2 * t0[i] * t1[i];
            float o[8];
#pragma unroll
            for (int i = 0; i < 8; ++i) { const float w0 = a.conv_w_mix[c0 + i], w1 = a.conv_w_mix[CW + c0 + i], w2 = a.conv_w_mix[2 * CW + c0 + i], bb = a.conv_b_mix[c0 + i];
                o[i] = gb[i] * (w0 * p2[i] + w1 * p1[i] + w2 * p0[i] + bb); }
            *(u32x4*)(MIXIN + (size_t)row * DM + CW + c0) = pack8f(o);
        }
    }
}

__device__ __forceinline__ void ph_post_mix(const Args& a, int gw, int NGW, int lane) {
    unsigned char* ws = a.ws; const bf16_t* MIX = (const bf16_t*)(ws + WS_PROJ); const float* mod = (const float*)(ws + WS_MOD); bf16_t* XN2 = (bf16_t*)(ws + WS_XN);
    for (int row0 = gw; row0 < M; row0 += 2 * NGW) {
      int rows[2]; rows[0] = row0; rows[1] = row0 + NGW < M ? row0 + NGW : row0;
      u32x4 wq[2][4]; f32x4 xq[2][8];
#pragma unroll
      for (int q = 0; q < 2; ++q) { const f32x4* xr = (const f32x4*)(a.x + (size_t)rows[q] * DM) + 2 * lane;
#pragma unroll
          for (int j = 0; j < 4; ++j) { wq[q][j] = *(const u32x4*)(MIX + (size_t)rows[q] * DM + (lane + 64 * j) * 8); xq[q][2 * j] = xr[128 * j]; xq[q][2 * j + 1] = xr[128 * j + 1]; } }
#pragma unroll
      for (int q = 0; q < 2; ++q) {
        const int row = rows[q];
        const float* mb = mod + (row >= SEQ ? NMODC : 0);
        f32x4 v[8], xv[8]; float ss = 0.f;
#pragma unroll
        for (int j = 0; j < 4; ++j) { const u32x4 w = wq[q][j]; xv[2 * j] = xq[q][2 * j]; xv[2 * j + 1] = xq[q][2 * j + 1];
            v[2 * j] = (f32x4){bflo(w.x), bfhi(w.x), bflo(w.y), bfhi(w.y)}; v[2 * j + 1] = (f32x4){bflo(w.z), bfhi(w.z), bflo(w.w), bfhi(w.w)}; }
#pragma unroll
        for (int j = 0; j < 8; ++j) ss += (v[j][0] * v[j][0] + v[j][1] * v[j][1]) + (v[j][2] * v[j][2] + v[j][3] * v[j][3]);
        const float rstd = rsqrtf(wave_sum(ss) * (1.f / DM) + RMS_EPS);
        float ss2 = 0.f;
#pragma unroll
        for (int j = 0; j < 8; ++j) { const int e = (lane + 64 * (j >> 1)) * 8 + (j & 1) * 4;
            const f32x4 g4 = *(const f32x4*)(a.g_post_mix + e), gt = *(const f32x4*)(mb + 2 * DM + e);
            const f32x4 x1 = xv[j] + gt * (v[j] * rstd * g4);
            *(f32x4*)(a.out + (size_t)row * DM + e) = x1; v[j] = x1;
            ss2 += (x1[0] * x1[0] + x1[1] * x1[1]) + (x1[2] * x1[2] + x1[3] * x1[3]); }
        const float rstd2 = rsqrtf(wave_sum(ss2) * (1.f / DM) + RMS_EPS);
#pragma unroll
        for (int j = 0; j < 4; ++j) { const int e = (lane + 64 * j) * 8; f32x4 o[2];
#pragma unroll
            for (int hh = 0; hh < 2; ++hh) { const f32x4 g4 = *(const f32x4*)(a.g_pre_ffn + e + 4 * hh), s4 = *(const f32x4*)(mb + 4 * DM + e + 4 * hh), h4 = *(const f32x4*)(mb + 3 * DM + e + 4 * hh);
                o[hh] = v[2 * j + hh] * rstd2 * g4 * (s4 + 1.f) + h4; }
            *(u32x4*)(XN2 + (size_t)row * DM + e) = (u32x4){pk2(o[0][0], o[0][1]), pk2(o[0][2], o[0][3]), pk2(o[1][0], o[1][1]), pk2(o[1][2], o[1][3])}; }
      }
    }
}

__device__ __forceinline__ void ph_act(const Args& a, int t0, int ntiles, int gt, int NGT) {
    unsigned char* ws = a.ws; const bf16_t* U = (const bf16_t*)(ws + WS_U); bf16_t* ACT = (bf16_t*)(ws + WS_ACT);
    const int Np = ntiles * 256, nch = ntiles * 16, total = (M / 8) * nch;
    for (int idx = gt; idx < total; idx += NGT) {
        const int rb = idx / nch, ch = idx - rb * nch, tile = ch >> 4, cc = ch & 15;
        const int ucol = tile * 256 + cc * 8, acol = (t0 + tile) * 128 + cc * 8;
        float wa[3][8], wg[3][8], ba[8], bg[8];
#pragma unroll
        for (int k = 0; k < 3; ++k) {
            const f32x4 q0 = *(const f32x4*)(a.conv_w_ffn + k * NUP + acol), q1 = *(const f32x4*)(a.conv_w_ffn + k * NUP + acol + 4);
            const f32x4 r0 = *(const f32x4*)(a.conv_w_ffn + k * NUP + DFF + acol), r1 = *(const f32x4*)(a.conv_w_ffn + k * NUP + DFF + acol + 4);
#pragma unroll
            for (int i = 0; i < 4; ++i) { wa[k][i] = q0[i]; wa[k][4 + i] = q1[i]; wg[k][i] = r0[i]; wg[k][4 + i] = r1[i]; } }
        { const f32x4 q0 = *(const f32x4*)(a.conv_b_ffn + acol), q1 = *(const f32x4*)(a.conv_b_ffn + acol + 4);
          const f32x4 r0 = *(const f32x4*)(a.conv_b_ffn + DFF + acol), r1 = *(const f32x4*)(a.conv_b_ffn + DFF + acol + 4);
#pragma unroll
          for (int i = 0; i < 4; ++i) { ba[i] = q0[i]; ba[4 + i] = q1[i]; bg[i] = r0[i]; bg[4 + i] = r1[i]; } }
        const int r0w = rb * 8; const bool first = (r0w & (SEQ - 1)) == 0;
        float a1[8], a2[8], g1[8], g2[8];
#pragma unroll
        for (int i = 0; i < 8; ++i) { a1[i] = 0.f; a2[i] = 0.f; g1[i] = 0.f; g2[i] = 0.f; }
        if (!first) { const bf16_t* up = U + (size_t)(r0w - 2) * Np + ucol;
            unpack8(*(const u32x4*)up, a2); unpack8(*(const u32x4*)(up + 128), g2); unpack8(*(const u32x4*)(up + Np), a1); unpack8(*(const u32x4*)(up + Np + 128), g1); }
#pragma unroll
        for (int r = 0; r < 8; ++r) { const bf16_t* up = U + (size_t)(r0w + r) * Np + ucol;
            float a0[8], g0[8], o[8]; unpack8(*(const u32x4*)up, a0); unpack8(*(const u32x4*)(up + 128), g0);
#pragma unroll
            for (int i = 0; i < 8; ++i) { const float ua = wa[0][i] * a2[i] + wa[1][i] * a1[i] + wa[2][i] * a0[i] + ba[i];
                const float ug = wg[0][i] * g2[i] + wg[1][i] * g1[i] + wg[2][i] * g0[i] + bg[i];
                o[i] = ua * ug * __builtin_amdgcn_rcpf(1.f + __expf(-ug)); a2[i] = a1[i]; a1[i] = a0[i]; g2[i] = g1[i]; g1[i] = g0[i]; }
            *(u32x4*)(ACT + (size_t)(r0w + r) * DFF + acol) = pack8f(o); }
    }
}

__device__ __forceinline__ void ph_final(const Args& a, int gw, int NGW, int lane) {
    unsigned char* ws = a.ws; const bf16_t* Y = (const bf16_t*)(ws + WS_Y); const float* mod = (const float*)(ws + WS_MOD);
    for (int row0 = gw; row0 < M; row0 += 2 * NGW) {
      int rows[2]; rows[0] = row0; rows[1] = row0 + NGW < M ? row0 + NGW : row0;
      u32x4 wq[2][4]; f32x4 xq[2][8];
#pragma unroll
      for (int q = 0; q < 2; ++q) { const f32x4* xr = (const f32x4*)(a.out + (size_t)rows[q] * DM) + 2 * lane;
#pragma unroll
          for (int j = 0; j < 4; ++j) { wq[q][j] = *(const u32x4*)(Y + (size_t)rows[q] * DM + (lane + 64 * j) * 8); xq[q][2 * j] = xr[128 * j]; xq[q][2 * j + 1] = xr[128 * j + 1]; } }
#pragma unroll
      for (int q = 0; q < 2; ++q) {
        const int row = rows[q];
        if (q == 1 && rows[1] == rows[0]) break;
        const float* mb = mod + (row >= SEQ ? NMODC : 0);
        f32x4 v[8], xv[8]; float ss = 0.f;
#pragma unroll
        for (int j = 0; j < 4; ++j) { const u32x4 w = wq[q][j]; xv[2 * j] = xq[q][2 * j]; xv[2 * j + 1] = xq[q][2 * j + 1];
            v[2 * j] = (f32x4){bflo(w.x), bfhi(w.x), bflo(w.y), bfhi(w.y)}; v[2 * j + 1] = (f32x4){bflo(w.z), bfhi(w.z), bflo(w.w), bfhi(w.w)}; }
#pragma unroll
        for (int j = 0; j < 8; ++j) ss += (v[j][0] * v[j][0] + v[j][1] * v[j][1]) + (v[j][2] * v[j][2] + v[j][3] * v[j][3]);
        const float rstd = rsqrtf(wave_sum(ss) * (1.f / DM) + RMS_EPS);
#pragma unroll
        for (int j = 0; j < 8; ++j) { const int e = (lane + 64 * (j >> 1)) * 8 + (j & 1) * 4;
            const f32x4 g4 = *(const f32x4*)(a.g_post_ffn + e), gt = *(const f32x4*)(mb + 5 * DM + e);
            *(f32x4*)(a.out + (size_t)row * DM + e) = xv[j] + gt * (v[j] * rstd * g4); }
      }
    }
}

#ifndef PROBE_THIN
#define PROBE_THIN 1
#endif
#ifndef PROBE_ATT
#define PROBE_ATT 1
#endif
constexpr int LDS_MISC = 131072 + 256;
constexpr size_t WS_BAR = 67 * MiB, BAR_BYTES = 16384;
#ifndef STAGGER_TICKS
#define STAGGER_TICKS 0
#endif
__device__ __forceinline__ void stagger(int bid) {
    if (STAGGER_TICKS > 0) {
        if (threadIdx.x == 0) { const unsigned long long t0 = __builtin_amdgcn_s_memrealtime(); const unsigned long long d = (unsigned long long)(((bid >> 3) & 7) * STAGGER_TICKS);
            while (__builtin_amdgcn_s_memrealtime() - t0 < d) __builtin_amdgcn_s_sleep(8); }
        __syncthreads();
    }
}
__global__ void __launch_bounds__(NTHREADS, 2) mega_fwd(Args a) {
    extern __shared__ __attribute__((aligned(16))) unsigned char lds_raw[];
    cg::grid_group grid = cg::this_grid();
    LAS unsigned char* lds = (LAS unsigned char*)lds_raw;
    const int tid = threadIdx.x, lane = tid & 63, wave = __builtin_amdgcn_readfirstlane(tid >> 6);
    const int G = gridDim.x, bid = blockIdx.x;
    const int gw = bid * NWAVES + wave, NGW = G * NWAVES, gt = bid * NTHREADS + tid, NGT = G * NTHREADS;
    unsigned char* ws = a.ws;
    bf16_t* XN = (bf16_t*)(ws + WS_XN);
    volatile LAS unsigned* misc = (volatile LAS unsigned*)(lds + LDS_MISC);
    if (tid < 2) misc[tid] = 0u;
    __syncthreads();
    const XcdBarrier xbar = xcd_barrier_post((unsigned*)(ws + WS_BAR), misc);
    if (a.out == nullptr) grid.sync();
#define GRID_BAR() xcd_barrier(xbar)

    ph_prologue(a, lds, G);
    GRID_BAR();
    for (int rep = 0; rep < PROBE_THIN; ++rep) ph_prenorm(a.x, a.g_pre_mix, (const float*)(ws + WS_MOD), 0, 1, XN, gw, NGW, lane);
    GRID_BAR();
    {
        Gemm g{XN, (const bf16_t*)(ws + WS_WIN), M, INP, DM}; StaticOrder S; S.init(M, INP, G, bid);
        pg8::EpiBf16 E{(bf16_t*)(ws + WS_PROJ), INP};
        stagger(bid); gemm_phase<pg8::EpiBf16, StaticOrder, true, true>(lds, g, S, E);
        const int nwg = (M / 256) * (INP / 256), full = nwg / G, rem = nwg - full * G;
        if (rem == 0) ph_deferred(a, lds, bid, G); else if (bid >= rem) ph_deferred(a, lds, bid - rem, G - rem);
    }
    GRID_BAR();
    for (int rep = 0; rep < PROBE_THIN; ++rep) ph_mid(a, gw, NGW, lane);
    GRID_BAR();
    {
        Gemm g{(const bf16_t*)(ws + WS_QN), (const bf16_t*)(ws + WS_WUQ), M, NQ, QL}; StaticOrder S; S.init(M, NQ, G, bid);
        pg8::EpiQ E{(bf16_t*)(ws + WS_Q), (const float*)(ws + WS_CS)};
        stagger(bid); gemm_phase<pg8::EpiQ, StaticOrder, true, true>(lds, g, S, E);
        Gemm g2{(const bf16_t*)(ws + WS_KVN), (const bf16_t*)(ws + WS_WUKV), M, NKV, KVL}; StaticOrder S2; S2.init(M, NKV, G, bid);
        pg8::EpiBf16 E2{(bf16_t*)(ws + WS_KV), NKV};
        gemm_phase<pg8::EpiBf16, StaticOrder, true, true>(lds, g2, S2, E2);
    }
    GRID_BAR();
    {
        for (int rep = 0; rep < PROBE_ATT; ++rep)
        for (int L = bid; L < 256; L += G) {
            const int v = (L & 7) * 32 + (L >> 3), bh = v >> 4, s = v & 15;
            att::attn_unit(bh >> 3, bh & 7, 31 - s, (const bf16_t*)(ws + WS_Q), (const bf16_t*)(ws + WS_KV), (const bf16_t*)(ws + WS_KR), XN, (char*)lds_raw);
            att::attn_unit(bh >> 3, bh & 7, s, (const bf16_t*)(ws + WS_Q), (const bf16_t*)(ws + WS_KV), (const bf16_t*)(ws + WS_KR), XN, (char*)lds_raw);
        }
    }
    GRID_BAR();
    {
        Gemm g{XN, (const bf16_t*)(ws + WS_WO), M, DM, DM}; StaticOrder S; S.init(M, DM, G, bid);
        pg8::EpiBf16 E{(bf16_t*)(ws + WS_PROJ), DM};
        stagger(bid); gemm_phase<pg8::EpiBf16, StaticOrder, true, true>(lds, g, S, E);
    }
    GRID_BAR();
    for (int rep = 0; rep < PROBE_THIN; ++rep) ph_post_mix(a, gw, NGW, lane);
    GRID_BAR();
    {
        Gemm g{XN, (const bf16_t*)(ws + WS_WUP), M, UP_TA * 256, DM}; StaticOrder S; S.init(M, UP_TA * 256, G, bid);
        pg8::EpiBf16 E{(bf16_t*)(ws + WS_U), UP_TA * 256};
        stagger(bid); gemm_phase<pg8::EpiBf16, StaticOrder, true, true>(lds, g, S, E);
    }
    GRID_BAR();
    for (int rep = 0; rep < PROBE_THIN; ++rep) ph_act(a, 0, UP_TA, gt, NGT);
    GRID_BAR();
    {
        Gemm g{XN, (const bf16_t*)(ws + WS_WUP) + (size_t)UP_TA * 256 * DM, M, UP_TB * 256, DM}; StaticOrder S; S.init(M, UP_TB * 256, G, bid);
        pg8::EpiBf16 E{(bf16_t*)(ws + WS_U), UP_TB * 256};
        stagger(bid); gemm_phase<pg8::EpiBf16, StaticOrder, true, true>(lds, g, S, E);
    }
    GRID_BAR();
    for (int rep = 0; rep < PROBE_THIN; ++rep) ph_act(a, UP_TA, UP_TB, gt, NGT);
    GRID_BAR();
    {
        Gemm g{(const bf16_t*)(ws + WS_ACT), (const bf16_t*)(ws + WS_WDN), M, DM, DFF}; StaticOrder S; S.init(M, DM, G, bid);
        pg8::EpiBf16 E{(bf16_t*)(ws + WS_Y), DM};
        stagger(bid); gemm_phase<pg8::EpiBf16, StaticOrder, true, true>(lds, g, S, E);
    }
    GRID_BAR();
    ph_final(a, gw, NGW, lane);
}

extern "C" void kernel_launch(void* const* d_in, const int* in_sizes, int n_in, void* d_out, int out_size, void* d_ws, size_t ws_size, hipStream_t stream) {
    static int grid = 0;
    if (grid == 0) {
        if (n_in != 21 || in_sizes[0] != M * DM || out_size != M * DM || ws_size < WS_END) {
            fprintf(stderr, "kernel_launch: unexpected shapes (n_in %d, in0 %d, out %d, ws %zu; need ws >= %zu)\n", n_in, n_in > 0 ? in_sizes[0] : -1, out_size, ws_size, (size_t)WS_END); grid = -1; return; }
        int dev = 0, cus = 0, per_cu = 0;
        (void)hipGetDevice(&dev);
        (void)hipDeviceGetAttribute(&cus, hipDeviceAttributeMultiprocessorCount, dev);
        if (hipFuncSetAttribute((const void*)mega_fwd, hipFuncAttributeMaxDynamicSharedMemorySize, LDS_BYTES) != hipSuccess) { fprintf(stderr, "kernel_launch: hipFuncSetAttribute failed\n"); grid = -1; return; }
        if (hipOccupancyMaxActiveBlocksPerMultiprocessor(&per_cu, (const void*)mega_fwd, NTHREADS, LDS_BYTES) != hipSuccess || per_cu < 1) { fprintf(stderr, "kernel_launch: occupancy query failed (%d)\n", per_cu); (void)hipGetLastError(); per_cu = 1; }
        grid = cus * per_cu;
        fprintf(stderr, "kernel_launch: %d CUs x %d workgroups\n", cus, per_cu);
    }
    if (grid < 0) return;
    if (hipMemsetAsync((char*)d_ws + WS_BAR, 0, BAR_BYTES, stream) != hipSuccess) { fprintf(stderr, "kernel_launch: memset failed\n"); return; }
    Args a{};
    a.x = (const float*)d_in[0]; a.c = (const float*)d_in[1]; a.pos = (const int*)d_in[2]; a.w_ada = (const float*)d_in[3]; a.b_ada = (const float*)d_in[4];
    a.g_pre_mix = (const float*)d_in[5]; a.g_post_mix = (const float*)d_in[6]; a.w_in = (const float*)d_in[7]; a.g_q = (const float*)d_in[8]; a.w_uq = (const float*)d_in[9];
    a.g_kv = (const float*)d_in[10]; a.w_ukv = (const float*)d_in[11]; a.conv_w_mix = (const float*)d_in[12]; a.conv_b_mix = (const float*)d_in[13]; a.w_o = (const float*)d_in[14];
    a.g_pre_ffn = (const float*)d_in[15]; a.g_post_ffn = (const float*)d_in[16]; a.w_up = (const float*)d_in[17]; a.conv_w_ffn = (const float*)d_in[18]; a.conv_b_ffn = (const float*)d_in[19];
    a.w_down = (const float*)d_in[20]; a.out = (float*)d_out; a.ws = (unsigned char*)d_ws;
    void* args[] = {&a};
    hipError_t e = hipLaunchCooperativeKernel((const void*)mega_fwd, dim3(grid), dim3(NTHREADS), args, LDS_BYTES, stream);
    if (e != hipSuccess) fprintf(stderr, "kernel_launch: cooperative launch failed: %s (grid %d)\n", hipGetErrorString(e), grid);
}
```

```cpp
#include <hip/hip_runtime.h>
#include <hip/hip_cooperative_groups.h>
#include <cstdio>
#include <cstdint>
namespace cg = cooperative_groups;

constexpr int BATCH = 2, SEQ = 8192, DM = 2048, M = BATCH * SEQ;
constexpr int QL = 768, KVL = 512, ROPE = 64, CW = 1024, INC = 4416, INP = 4608;
constexpr int NH = 8, DQK = 192, NQ = NH * DQK  , NKV = NH * 256  ;
constexpr int DFF = 5632, NUP = 2 * DFF;
constexpr int NMODC = 6 * DM;
constexpr float RMS_EPS = 1e-6f;
constexpr int PC_Q = 0, PC_KV = 768, PC_GB = 1280, PC_GC = 2304, PC_CI = 3328, PC_KR = 4352;
constexpr int UP_TA = 20, UP_TB = 24;

constexpr size_t MiB = 1u << 20;
constexpr size_t WS_WUP = 0, WS_WDN = 44 * MiB, WS_MOD = 66 * MiB;
constexpr size_t WS_XN = 68 * MiB;
constexpr size_t WS_WIN = 132 * MiB, WS_WUQ = 150 * MiB, WS_WUKV = 153 * MiB, WS_WO = 155 * MiB, WS_CS = 163 * MiB;
constexpr size_t WS_PROJ = 168 * MiB;
constexpr size_t WS_QN = 312 * MiB, WS_KVN = 336 * MiB, WS_KR = 352 * MiB, WS_Q = 354 * MiB, WS_KV = 402 * MiB;
constexpr size_t WS_HL = 300 * MiB, WS_HF = 308 * MiB;
constexpr size_t WS_ACT = 324 * MiB;
constexpr size_t WS_Y = 132 * MiB;
constexpr size_t WS_END = 500 * MiB;

#define LAS __attribute__((address_space(3)))
typedef unsigned u32x4 __attribute__((ext_vector_type(4)));
typedef unsigned u32x2 __attribute__((ext_vector_type(2)));
typedef float f32x2 __attribute__((ext_vector_type(2)));
typedef unsigned short bf16_t;
typedef short bf16x8 __attribute__((ext_vector_type(8)));
typedef short s16x4 __attribute__((ext_vector_type(4)));
typedef float f32x4 __attribute__((ext_vector_type(4)));
typedef float f32x16 __attribute__((ext_vector_type(16)));
namespace pg8 {
#define PG8_LAS __attribute__((address_space(3)))
typedef unsigned short bf16_t;
typedef short bf16x8 __attribute__((ext_vector_type(8)));
typedef float f32x4 __attribute__((ext_vector_type(4)));
typedef unsigned u32x4 __attribute__((ext_vector_type(4)));
constexpr int BM = 256, BK = 64, HALF = 128, HTB = HALF * BK * 2  , STAGE_BYTES = 8 * HTB, NXCD = 8, WGM = 8;

__host__ __device__ __forceinline__ int lds_byte(int r, int c) { const int st = (r >> 4) * 2 + (c >> 5), rr = r & 15, cc = c & 31, ob = rr * 64 + cc * 2; return st * 1024 + (ob ^ (((ob >> 9) & 1) << 5)); }
__host__ __device__ __forceinline__ void stage_rc(int b, int& R, int& C) { const int st = b / 1024, sb = b % 1024, swz = sb ^ (((sb >> 9) & 1) << 5); R = (st >> 1) * 16 + swz / 64; C = (st & 1) * 32 + (swz % 64) / 2; }
__host__ __device__ __forceinline__ int perm32(int rho) { const int n = rho >> 4, i = rho & 15; return 8 * (i >> 2) + 4 * n + (i & 3); }

struct Unit { int pm, pn; };
struct Gemm { const bf16_t* A; const bf16_t* Bt; int M, N, K; };

struct StaticOrder {
    int nM, nN, nwg, G, c;
    __host__ __device__ void init(int M, int N, int G_, int c_) { nM = M / BM; nN = N / BM; nwg = nM * nN; G = G_; c = c_; }
    __host__ __device__ bool next(int i, Unit& u) const {
        const long L = (long)i * G + c; if (L >= nwg) return false;
        int wgid = (int)L; { const int q = nwg / NXCD, r = nwg % NXCD, xcd = wgid % NXCD, off = wgid / NXCD; wgid = (xcd < r ? xcd * (q + 1) : r * (q + 1) + (xcd - r) * q) + off; }
        const int nig = WGM * nN, gid = wgid / nig, fm = gid * WGM, gsz = (nM - fm) < WGM ? (nM - fm) : WGM;
        u.pm = fm + ((wgid % nig) % gsz); u.pn = (wgid % nig) / gsz; return true;
    }
    __device__ __forceinline__ void a_ready(const Unit&) const {}
    __device__ __forceinline__ void done(const Unit&) const {}
};

__device__ __forceinline__ unsigned cvt_pk_bf16(float lo, float hi) { unsigned r; asm volatile("v_cvt_pk_bf16_f32 %0, %1, %2" : "=v"(r) : "v"(lo), "v"(hi)); return r; }
struct EpiBf16 {
    static constexpr bool PERM = true, AFTER_DRAIN = false, ROWPERM = false;
    bf16_t* O; int ldc;
    __device__ __forceinline__ void operator()(const f32x4 (&acc)[2][2][4][2], const Unit& u, int wr, int wc, int fr, int fq) const {
        const int row0 = u.pm * BM + wr * 64 + fr, col0 = u.pn * BM + wc * 32 + 8 * fq;
#pragma unroll
        for (int ai = 0; ai < 2; ++ai)
#pragma unroll
            for (int m = 0; m < 4; ++m) { bf16_t* rowp = O + (size_t)(row0 + ai * HALF + m * 16) * ldc + col0;
#pragma unroll
                for (int bj = 0; bj < 2; ++bj) { const f32x4 v0 = acc[ai][bj][m][0], v1 = acc[ai][bj][m][1];
                    u32x4 w; w.x = cvt_pk_bf16(v0[0], v0[1]); w.y = cvt_pk_bf16(v0[2], v0[3]); w.z = cvt_pk_bf16(v1[0], v1[1]); w.w = cvt_pk_bf16(v1[2], v1[3]);
                    *(u32x4*)(rowp + bj * HALF) = w; } }
    }
};
struct EpiBf16NT {
    static constexpr bool PERM = true, AFTER_DRAIN = false, ROWPERM = false;
    bf16_t* O; int ldc;
    __device__ __forceinline__ void operator()(const f32x4 (&acc)[2][2][4][2], const Unit& u, int wr, int wc, int fr, int fq) const {
        const int row0 = u.pm * BM + wr * 64 + fr, col0 = u.pn * BM + wc * 32 + 8 * fq;
#pragma unroll
        for (int ai = 0; ai < 2; ++ai)
#pragma unroll
            for (int m = 0; m < 4; ++m) { bf16_t* rowp = O + (size_t)(row0 + ai * HALF + m * 16) * ldc + col0;
#pragma unroll
                for (int bj = 0; bj < 2; ++bj) { const f32x4 v0 = acc[ai][bj][m][0], v1 = acc[ai][bj][m][1];
                    u32x4 w; w.x = cvt_pk_bf16(v0[0], v0[1]); w.y = cvt_pk_bf16(v0[2], v0[3]); w.z = cvt_pk_bf16(v1[0], v1[1]); w.w = cvt_pk_bf16(v1[2], v1[3]);
                    __builtin_nontemporal_store(w, (u32x4*)(rowp + bj * HALF)); } }
    }
};
struct EpiF32 {
    static constexpr bool PERM = true, AFTER_DRAIN = false, ROWPERM = false;
    float* O; int ldc;
    __device__ __forceinline__ void operator()(const f32x4 (&acc)[2][2][4][2], const Unit& u, int wr, int wc, int fr, int fq) const {
        const int row0 = u.pm * BM + wr * 64 + fr, col0 = u.pn * BM + wc * 32 + 8 * fq;
#pragma unroll
        for (int ai = 0; ai < 2; ++ai)
#pragma unroll
            for (int m = 0; m < 4; ++m) { float* rowp = O + (size_t)(row0 + ai * HALF + m * 16) * ldc + col0;
#pragma unroll
                for (int bj = 0; bj < 2; ++bj) { *(f32x4*)(rowp + bj * HALF) = acc[ai][bj][m][0]; *(f32x4*)(rowp + bj * HALF + 4) = acc[ai][bj][m][1]; } }
    }
};
struct EpiQ {
    static constexpr bool PERM = true, AFTER_DRAIN = false, ROWPERM = false;
    bf16_t* O; const float* CS;
    __device__ __forceinline__ void operator()(const f32x4 (&acc)[2][2][4][2], const Unit& u, int wr, int wc, int fr, int fq) const {
        const int row0 = u.pm * BM + wr * 64 + fr;
#pragma unroll
        for (int bj = 0; bj < 2; ++bj) {
            const int cb = u.pn * BM + bj * HALF + wc * 32, within = cb % 192; const bool rope = within >= 128;
            const int j0 = ((within - 128) >> 1) + 4 * fq;
#pragma unroll
            for (int ai = 0; ai < 2; ++ai)
#pragma unroll
                for (int m = 0; m < 4; ++m) { const int row = row0 + ai * HALF + m * 16;
                    f32x4 v0 = acc[ai][bj][m][0], v1 = acc[ai][bj][m][1];
                    if (rope) { const f32x4 c0 = *(const f32x4*)(CS + (size_t)row * 64 + j0 * 2), c1 = *(const f32x4*)(CS + (size_t)row * 64 + j0 * 2 + 4);
                        f32x4 a, b;
                        a[0] = v0[0] * c0[0] - v0[1] * c0[1]; a[1] = v0[1] * c0[0] + v0[0] * c0[1]; a[2] = v0[2] * c0[2] - v0[3] * c0[3]; a[3] = v0[3] * c0[2] + v0[2] * c0[3];
                        b[0] = v1[0] * c1[0] - v1[1] * c1[1]; b[1] = v1[1] * c1[0] + v1[0] * c1[1]; b[2] = v1[2] * c1[2] - v1[3] * c1[3]; b[3] = v1[3] * c1[2] + v1[2] * c1[3];
                        v0 = a; v1 = b; }
                    u32x4 w; w.x = cvt_pk_bf16(v0[0], v0[1]); w.y = cvt_pk_bf16(v0[2], v0[3]); w.z = cvt_pk_bf16(v1[0], v1[1]); w.w = cvt_pk_bf16(v1[2], v1[3]);
                    *(u32x4*)(O + (size_t)row * NQ + cb + 8 * fq) = w; }
        }
    }
};

__device__ __forceinline__ float dpp_shr1(float v) { return __int_as_float(__builtin_amdgcn_mov_dpp(__float_as_int(v), 0x111, 0xf, 0xf, true)); }
struct EpiAct {
    static constexpr bool PERM = true, AFTER_DRAIN = false, ROWPERM = true;
    bf16_t* ACT; const float* cw; const float* cb; float* HL; float* HF; PG8_LAS float* X; int ntn, nff;
    __device__ __forceinline__ void operator()(const f32x4 (&acc)[2][2][4][2], const Unit& u, int wr, int wc, int fr, int fq) const {
        const int unit = u.pm * ntn + u.pn, chl = 32 * wc + 8 * fq;
        if (wr == 0 && fr == 15) { PG8_LAS float* xp = X + (wc * 4 + fq) * 32;
#pragma unroll
            for (int t2 = 0; t2 < 2; ++t2)
#pragma unroll
                for (int bj = 0; bj < 2; ++bj)
#pragma unroll
                    for (int n = 0; n < 2; ++n) *(PG8_LAS f32x4*)(xp + (t2 * 2 + bj) * 8 + n * 4) = acc[1][bj][2 + t2][n]; }
        if (wr == 1 && fr == 15) { float* hp = HL + (size_t)unit * 512 + chl;
#pragma unroll
            for (int t2 = 0; t2 < 2; ++t2)
#pragma unroll
                for (int bj = 0; bj < 2; ++bj)
#pragma unroll
                    for (int n = 0; n < 2; ++n) *(f32x4*)(hp + (t2 * 2 + bj) * 128 + n * 4) = acc[1][bj][2 + t2][n]; }
        if (wr == 0 && fr == 0) { float* hp = HF + (size_t)unit * 512 + chl;
#pragma unroll
            for (int t2 = 0; t2 < 2; ++t2)
#pragma unroll
                for (int bj = 0; bj < 2; ++bj)
#pragma unroll
                    for (int n = 0; n < 2; ++n) *(f32x4*)(hp + (t2 * 2 + bj) * 128 + n * 4) = acc[0][bj][t2][n]; }
        asm volatile("s_waitcnt lgkmcnt(0)" ::: "memory"); __builtin_amdgcn_s_barrier(); asm volatile("" ::: "memory");
        u32x4 outp[8];
#pragma unroll
        for (int n = 0; n < 2; ++n) {
            const int chg = u.pn * 128 + chl + 4 * n;
            f32x4 wa[3], wg[3];
#pragma unroll
            for (int k = 0; k < 3; ++k) { wa[k] = *(const f32x4*)(cw + (size_t)k * 2 * nff + chg); wg[k] = *(const f32x4*)(cw + (size_t)k * 2 * nff + nff + chg); }
            const f32x4 ba = *(const f32x4*)(cb + chg), bg = *(const f32x4*)(cb + nff + chg);
            f32x4 a1, a2, g1, g2;
#pragma unroll
            for (int j = 0; j < 4; ++j) { a1[j] = dpp_shr1(acc[1][0][3][n][j]); a2[j] = dpp_shr1(acc[1][0][2][n][j]); g1[j] = dpp_shr1(acc[1][1][3][n][j]); g2[j] = dpp_shr1(acc[1][1][2][n][j]); }
            if (wr == 1 && fr == 0) { const PG8_LAS float* xp = X + (wc * 4 + fq) * 32 + n * 4;
                a2 = *(const PG8_LAS f32x4*)(xp + 0); g2 = *(const PG8_LAS f32x4*)(xp + 8); a1 = *(const PG8_LAS f32x4*)(xp + 16); g1 = *(const PG8_LAS f32x4*)(xp + 24); }
#pragma unroll
            for (int tok = 0; tok < 8; ++tok) { const f32x4 a0 = acc[tok >> 2][0][tok & 3][n], g0 = acc[tok >> 2][1][tok & 3][n];
                const f32x4 ua = wa[0] * a2 + wa[1] * a1 + wa[2] * a0 + ba, ug = wg[0] * g2 + wg[1] * g1 + wg[2] * g0 + bg;
                f32x4 o;
#pragma unroll
                for (int j = 0; j < 4; ++j) o[j] = ua[j] * ug[j] * __builtin_amdgcn_rcpf(1.f + __expf(-ug[j]));
                const unsigned p0 = cvt_pk_bf16(o[0], o[1]), p1 = cvt_pk_bf16(o[2], o[3]);
                if (n == 0) { outp[tok].x = p0; outp[tok].y = p1; } else { outp[tok].z = p0; outp[tok].w = p1; }
                a2 = a1; a1 = a0; g2 = g1; g1 = g0; }
        }
        bf16_t* op = ACT + (size_t)(u.pm * BM + 8 * (16 * wr + fr)) * nff + u.pn * 128 + chl;
#pragma unroll
        for (int tok = 0; tok < 8; ++tok) *(u32x4*)(op + (size_t)tok * nff) = outp[tok];
    }
};
template <class Epi, class Sched, bool ALIGN_EPI = false, bool SP2 = false>
__device__ __forceinline__ void gemm_phase(PG8_LAS unsigned char* lds, const Gemm g, const Sched& S, const Epi& E) {
    int tid_o = threadIdx.x; asm volatile("" : "+v"(tid_o)); const int tid = tid_o, wid = __builtin_amdgcn_readfirstlane(tid >> 6), lane = tid & 63, wr = wid >> 2, wc = wid & 3, fr = lane & 15, fq = lane >> 4;
    const int K = g.K, nt = K / BK;
    unsigned voffA[2], voffB[2];
#pragma unroll
    for (int i = 0; i < 2; ++i) { int R, C; stage_rc(tid * 16 + i * 8192, R, C); const int Rb = Epi::PERM ? ((R & ~31) + perm32(R & 31)) : R;
        const int Ra = Epi::ROWPERM ? (8 * (16 * (R >> 6) + (R & 15)) + ((R >> 4) & 3)) : R;
        voffA[i] = (unsigned)(Ra * K + C) * 2u; voffB[i] = (unsigned)(Rb * K + C) * 2u; }
    const size_t kstep = (size_t)(BK * 2);
    const size_t hstep = (size_t)HALF * K * 2;
    const size_t hstepA = Epi::ROWPERM ? (size_t)4 * K * 2 : hstep;
    const size_t tstep = 2 * hstep;
    const unsigned ldsw = (unsigned)wid * 1024u;
    const int aoff = lds_byte(wr * 64 + fr, fq * 8), boff = lds_byte(wc * 32 + fr, fq * 8);
#define PG8_SA(b, h) (((b) * 2 + (h)) * HTB)
#define PG8_SB(b, h) ((4 + (b) * 2 + (h)) * HTB)
#define PG8_STAGE(bufoff, gbase, voff) do { _Pragma("unroll") for (int _i = 0; _i < 2; ++_i) \
        __builtin_amdgcn_global_load_lds((const unsigned*)((const char*)(gbase) + (voff)[_i]), (PG8_LAS unsigned*)(lds + (bufoff) + ldsw + _i * 8192), 16, 0, 0); } while (0)
#define PG8_LDA(dst, b, h) do { _Pragma("unroll") for (int m = 0; m < 4; ++m) _Pragma("unroll") for (int k = 0; k < 2; ++k) dst[m][k] = *(const PG8_LAS bf16x8*)(lds + PG8_SA(b, h) + aoff + m * 2048 + k * 1024); } while (0)
#define PG8_LDB(dst, b, h) do { _Pragma("unroll") for (int n = 0; n < 2; ++n) _Pragma("unroll") for (int k = 0; k < 2; ++k) dst[n][k] = *(const PG8_LAS bf16x8*)(lds + PG8_SB(b, h) + boff + n * 2048 + k * 1024); } while (0)
#define PG8_MMA(ai, bj, At, Bt) do { __builtin_amdgcn_s_setprio(1); _Pragma("unroll") for (int m = 0; m < 4; ++m) _Pragma("unroll") for (int n = 0; n < 2; ++n) _Pragma("unroll") for (int k = 0; k < 2; ++k) \
        acc[ai][bj][m][n] = __builtin_amdgcn_mfma_f32_16x16x32_bf16(Bt[n][k], At[m][k], acc[ai][bj][m][n], 0, 0, 0); __builtin_amdgcn_s_setprio(0); } while (0)
#define PG8_WAIT_V(n) asm volatile("s_waitcnt vmcnt(" #n ")" ::: "memory")
#define PG8_WAIT_L(n) asm volatile("s_waitcnt lgkmcnt(" #n ")" ::: "memory")
#define PG8_BAR __builtin_amdgcn_s_barrier()
#define PG8_SCHED __builtin_amdgcn_sched_barrier(0)
    Unit cur, nxt; int ui = 0;
    if (!S.next(0, cur)) return;
    f32x4 acc[2][2][4][2];
#pragma unroll
    for (int a = 0; a < 2; ++a)
#pragma unroll
        for (int b = 0; b < 2; ++b)
#pragma unroll
            for (int m = 0; m < 4; ++m)
#pragma unroll
                for (int n = 0; n < 2; ++n) acc[a][b][m][n] = (f32x4){0.f, 0.f, 0.f, 0.f};
    bf16x8 At[4][2], B0[2][2], B1[2][2];
    const char* cA = (const char*)g.A + (size_t)cur.pm * tstep; const char* cB = (const char*)g.Bt + (size_t)cur.pn * tstep;
    S.a_ready(cur);
    if constexpr (SP2) {
        PG8_STAGE(PG8_SB(0, 0), cB, voffB); PG8_STAGE(PG8_SB(0, 1), cB + hstep, voffB); PG8_STAGE(PG8_SA(0, 0), cA, voffA); PG8_STAGE(PG8_SA(0, 1), cA + hstepA, voffA);
        if (wr == 1) PG8_BAR;
        PG8_WAIT_V(2); PG8_BAR;
        PG8_STAGE(PG8_SB(1, 0), cB + kstep, voffB); PG8_STAGE(PG8_SA(1, 0), cA + kstep, voffA); PG8_STAGE(PG8_SB(1, 1), cB + hstep + kstep, voffB);
        PG8_WAIT_V(6); PG8_BAR;
    } else {
        PG8_STAGE(PG8_SB(0, 0), cB, voffB); PG8_STAGE(PG8_SA(0, 0), cA, voffA); PG8_STAGE(PG8_SB(0, 1), cB + hstep, voffB); PG8_STAGE(PG8_SA(0, 1), cA + hstepA, voffA);
        if (wr == 1) PG8_BAR;
        PG8_WAIT_V(4); PG8_BAR;
        PG8_STAGE(PG8_SB(1, 0), cB + kstep, voffB); PG8_STAGE(PG8_SA(1, 0), cA + kstep, voffA); PG8_STAGE(PG8_SB(1, 1), cB + hstep + kstep, voffB);
        PG8_WAIT_V(6); PG8_BAR;
    }
    for (;;) {
        const bool has_next = S.next(ui + 1, nxt);
        const char* nA = has_next ? (const char*)g.A + (size_t)nxt.pm * tstep : cA; const char* nB = has_next ? (const char*)g.Bt + (size_t)nxt.pn * tstep : cB;
        for (int t = 0; t < nt; t += 2) {
            const bool last = (t == nt - 2);
            const char* a1 = cA + (size_t)(t + 1) * kstep;
            const char* a2 = last ? nA : cA + (size_t)(t + 2) * kstep; const char* b2 = last ? nB : cB + (size_t)(t + 2) * kstep;
            const char* a3 = a2 + kstep; const char* b3 = b2 + kstep;
            if (last && has_next) S.a_ready(nxt);
            if constexpr (SP2) {
            PG8_LDB(B0, 0, 0); PG8_LDB(B1, 0, 1); PG8_SCHED; PG8_LDA(At, 0, 0); PG8_STAGE(PG8_SA(1, 1), a1 + hstepA, voffA);
            PG8_WAIT_V(8); PG8_WAIT_L(0); PG8_BAR; PG8_MMA(0, 0, At, B0); PG8_MMA(0, 1, At, B1); PG8_BAR; PG8_SCHED;
            PG8_LDA(At, 0, 1); PG8_STAGE(PG8_SB(0, 0), b2, voffB); PG8_STAGE(PG8_SB(0, 1), b2 + hstep, voffB); PG8_STAGE(PG8_SA(0, 0), a2, voffA);
            PG8_WAIT_V(8); PG8_WAIT_L(0); PG8_BAR; PG8_MMA(1, 0, At, B0); PG8_MMA(1, 1, At, B1); PG8_BAR; PG8_SCHED;
            PG8_LDB(B0, 1, 0); PG8_LDB(B1, 1, 1); PG8_SCHED; PG8_LDA(At, 1, 0); PG8_STAGE(PG8_SA(0, 1), a2 + hstepA, voffA);
            PG8_WAIT_V(8); PG8_WAIT_L(0); PG8_BAR; PG8_MMA(0, 0, At, B0); PG8_MMA(0, 1, At, B1); PG8_BAR; PG8_SCHED;
            PG8_LDA(At, 1, 1); PG8_STAGE(PG8_SB(1, 0), b3, voffB); PG8_STAGE(PG8_SB(1, 1), b3 + hstep, voffB); PG8_STAGE(PG8_SA(1, 0), a3, voffA);
            PG8_WAIT_V(8); PG8_WAIT_L(0); PG8_BAR; PG8_MMA(1, 0, At, B0); PG8_MMA(1, 1, At, B1); PG8_BAR; PG8_SCHED;
            } else {
            PG8_LDB(B0, 0, 0); PG8_SCHED; PG8_LDA(At, 0, 0); PG8_STAGE(PG8_SA(1, 1), a1 + hstepA, voffA);
            PG8_WAIT_L(8); PG8_BAR; PG8_WAIT_L(0); PG8_MMA(0, 0, At, B0); PG8_BAR; PG8_SCHED;
            PG8_LDB(B1, 0, 1); PG8_STAGE(PG8_SB(0, 0), b2, voffB);
            PG8_BAR; PG8_WAIT_L(0); PG8_MMA(0, 1, At, B1); PG8_BAR;
            PG8_LDA(At, 0, 1); PG8_STAGE(PG8_SA(0, 0), a2, voffA);
            PG8_BAR; PG8_WAIT_L(0); PG8_MMA(1, 0, At, B0); PG8_BAR; PG8_SCHED;
            PG8_STAGE(PG8_SB(0, 1), b2 + hstep, voffB);
            PG8_WAIT_V(6); PG8_BAR; PG8_MMA(1, 1, At, B1); PG8_BAR;
            PG8_LDB(B0, 1, 0); PG8_SCHED; PG8_LDA(At, 1, 0); PG8_STAGE(PG8_SA(0, 1), a2 + hstepA, voffA);
            PG8_WAIT_L(8); PG8_BAR; PG8_WAIT_L(0); PG8_MMA(0, 0, At, B0); PG8_BAR; PG8_SCHED;
            PG8_LDB(B1, 1, 1); PG8_STAGE(PG8_SB(1, 0), b3, voffB);
            PG8_BAR; PG8_WAIT_L(0); PG8_MMA(0, 1, At, B1); PG8_BAR;
            PG8_LDA(At, 1, 1); PG8_STAGE(PG8_SA(1, 0), a3, voffA);
            PG8_BAR; PG8_WAIT_L(0); PG8_MMA(1, 0, At, B0); PG8_BAR; PG8_SCHED;
            PG8_STAGE(PG8_SB(1, 1), b3 + hstep, voffB);
            PG8_WAIT_V(6); PG8_BAR; PG8_MMA(1, 1, At, B1); PG8_BAR;
            }
        }
        if constexpr (ALIGN_EPI) { if (wr == 0) PG8_BAR; }
        if constexpr (!Epi::AFTER_DRAIN) { E(acc, cur, wr, wc, fr, fq); S.done(cur); }
        if (!has_next) break;
#pragma unroll
        for (int a = 0; a < 2; ++a)
#pragma unroll
            for (int b = 0; b < 2; ++b)
#pragma unroll
                for (int m = 0; m < 4; ++m)
#pragma unroll
                    for (int n = 0; n < 2; ++n) acc[a][b][m][n] = (f32x4){0.f, 0.f, 0.f, 0.f};
        cur = nxt; cA = nA; cB = nB; ++ui;
        if constexpr (ALIGN_EPI) { if (wr == 1) PG8_BAR; }
    }
    PG8_WAIT_V(0);
    if constexpr (!ALIGN_EPI) { if (wr == 0) PG8_BAR; }
    PG8_BAR;
    if constexpr (Epi::AFTER_DRAIN) { E.fused(acc, cur, wr, wc, fr, fq, lds, wid, lane); S.done(cur); }
#undef PG8_SA
#undef PG8_SB
#undef PG8_STAGE
#undef PG8_LDA
#undef PG8_LDB
#undef PG8_MMA
#undef PG8_WAIT_V
#undef PG8_WAIT_L
#undef PG8_BAR
#undef PG8_SCHED
}
}
namespace att {
constexpr int NW = 8, QBLK = 32, KVBLK = 64, QB = NW * QBLK, DV = 128;
constexpr int KROW = 400;
constexpr int SHM_K = KVBLK * KROW, SHM_V = KVBLK * DV * 2;
constexpr int OFF_V = 0, OFF_K = 2 * SHM_V, OFF_WS = OFF_K + 2 * SHM_K, LDS_BYTES = OFF_WS + NW * 64 * 4;
constexpr float SCALE = 0.07216878364870322f;
constexpr float THR = 8.f;
#define SBAR() __builtin_amdgcn_sched_barrier(0)
__device__ __forceinline__ int v_st(int k, int c) { const int kk = (k & ~0xC) | ((k & 4) << 1) | ((k & 8) >> 1); return ((kk >> 3) * 4 + (c >> 5)) * 512 + ((kk & 7) * 32 + (c & 31)) * 2; }
__device__ __forceinline__ int v_rd_base(int lane) { return ((lane & 3) << 3) | (((lane >> 2) & 3) << 6) | (((lane >> 4) & 1) << 5) | (((lane >> 5) & 1) << 8); }
constexpr int v_rd_off(int d0, int ks, int half) { return d0 * 512 + ks * 4096 + half * 2048; }
__device__ __forceinline__ int crow(int r, int hi) { return (r & 3) + 8 * (r >> 2) + 4 * hi; }
__device__ __forceinline__ unsigned cvtpk(float lo, float hi) { unsigned r; asm volatile("v_cvt_pk_bf16_f32 %0, %1, %2" : "=v"(r) : "v"(lo), "v"(hi)); return r; }
__device__ __forceinline__ void mask_tile(f32x16& p0, f32x16& p1, int dq) {
    const float NEG = -__builtin_inff();
#pragma unroll
    for (int r = 0; r < 16; ++r) { const int c = (r & 3) + 8 * (r >> 2);
        if (dq - c < 0) p0[r] = NEG;
        if (dq - c - 32 < 0) p1[r] = NEG; }
}
__device__ __forceinline__ void partialSM(f32x16& p0, f32x16& p1, float& m_reg, float& mn, float& alpha) {
    float pmax = p0[0];
#pragma unroll
    for (int r = 1; r < 16; ++r) pmax = fmaxf(pmax, p0[r]);
#pragma unroll
    for (int r = 0; r < 16; ++r) pmax = fmaxf(pmax, p1[r]);
    { auto rr = __builtin_amdgcn_permlane32_swap(__float_as_uint(pmax), __float_as_uint(pmax), false, false);
      pmax = fmaxf(__uint_as_float(rr[0]), __uint_as_float(rr[1])); }
    constexpr float C2 = 1.4426950408889634f * SCALE;
    if (__builtin_expect(__all((pmax - m_reg) * SCALE <= THR), 1)) { mn = m_reg; alpha = 1.f; }
    else { mn = fmaxf(m_reg, pmax); alpha = __builtin_amdgcn_exp2f((m_reg - mn) * C2); m_reg = mn; }
    const float mnL = -mn * C2;
#pragma unroll
    for (int r = 0; r < 16; ++r) p0[r] = fmaf(p0[r], C2, mnL);
#pragma unroll
    for (int r = 0; r < 16; ++r) p1[r] = fmaf(p1[r], C2, mnL);
#pragma unroll
    for (int r = 0; r < 16; ++r) p0[r] = __builtin_amdgcn_exp2f(p0[r]);
}
__device__ __forceinline__ void finishSM(f32x16& p0, f32x16& p1, float alpha, float& l_reg, bf16x8& pa0, bf16x8& pa1, bf16x8& pa2, bf16x8& pa3) {
#pragma unroll
    for (int r = 0; r < 16; ++r) p1[r] = __builtin_amdgcn_exp2f(p1[r]);
    float ps = 0;
#pragma unroll
    for (int r = 0; r < 16; ++r) ps += p0[r];
#pragma unroll
    for (int r = 0; r < 16; ++r) ps += p1[r];
    { auto rr = __builtin_amdgcn_permlane32_swap(__float_as_uint(ps), __float_as_uint(ps), false, false);
      ps = __uint_as_float(rr[0]) + __uint_as_float(rr[1]); }
    l_reg = l_reg * alpha + ps;
#define PK4(P, B_, OUT) do { unsigned a0 = cvtpk(P[B_+0], P[B_+1]), a1 = cvtpk(P[B_+2], P[B_+3]);                          \
        unsigned b0 = cvtpk(P[B_+4], P[B_+5]), b1 = cvtpk(P[B_+6], P[B_+7]);                                             \
        auto r0 = __builtin_amdgcn_permlane32_swap(a0, b0, false, false); auto r1 = __builtin_amdgcn_permlane32_swap(a1, b1, false, false); \
        u32x4 w = {r0[0], r1[0], r0[1], r1[1]}; OUT = *reinterpret_cast<bf16x8*>(&w); } while (0)
    PK4(p0, 0, pa0); PK4(p0, 8, pa1); PK4(p1, 0, pa2); PK4(p1, 8, pa3);
#undef PK4
}
__device__ __forceinline__ void qkt(f32x16& p0, f32x16& p1, const char* Kb, int r32, int hi, const bf16x8* qr) {
    p0 = f32x16{}; p1 = f32x16{};
    const char* a = Kb + r32 * KROW + hi * 16;
#pragma unroll
    for (int d0 = 0; d0 < 12; ++d0) {
        const bf16x8 b0 = *reinterpret_cast<const bf16x8*>(a + d0 * 32);
        const bf16x8 b1 = *reinterpret_cast<const bf16x8*>(a + d0 * 32 + 32 * KROW);
        p0 = __builtin_amdgcn_mfma_f32_32x32x16_bf16(b0, qr[d0], p0, 0, 0, 0);
        p1 = __builtin_amdgcn_mfma_f32_32x32x16_bf16(b1, qr[d0], p1, 0, 0, 0); }
}
__device__ __forceinline__ void pv_tile(f32x16* o, int vb0, bf16x8 pa0, bf16x8 pa1, bf16x8 pa2, bf16x8 pa3) {
#define TRRD(dst, off) asm volatile("ds_read_b64_tr_b16 %0, %1 offset:%2" : "=&v"(dst) : "v"(vb0), "i"(off) : "memory")
#define PV_D0(d0) do { s16x4 l0, l1, l2, l3, h0, h1, h2, h3; constexpr int b_ = v_rd_off(d0, 0, 0); \
        TRRD(l0, b_); TRRD(h0, b_ + 2048); TRRD(l1, b_ + 4096); TRRD(h1, b_ + 6144); TRRD(l2, b_ + 8192); TRRD(h2, b_ + 10240); TRRD(l3, b_ + 12288); TRRD(h3, b_ + 14336); \
        asm volatile("s_waitcnt lgkmcnt(0)" ::: "memory"); SBAR();   \
        o[d0] = __builtin_amdgcn_mfma_f32_32x32x16_bf16(pa0, (bf16x8){l0[0], l0[1], l0[2], l0[3], h0[0], h0[1], h0[2], h0[3]}, o[d0], 0, 0, 0);   \
        o[d0] = __builtin_amdgcn_mfma_f32_32x32x16_bf16(pa1, (bf16x8){l1[0], l1[1], l1[2], l1[3], h1[0], h1[1], h1[2], h1[3]}, o[d0], 0, 0, 0);   \
        o[d0] = __builtin_amdgcn_mfma_f32_32x32x16_bf16(pa2, (bf16x8){l2[0], l2[1], l2[2], l2[3], h2[0], h2[1], h2[2], h2[3]}, o[d0], 0, 0, 0);   \
        o[d0] = __builtin_amdgcn_mfma_f32_32x32x16_bf16(pa3, (bf16x8){l3[0], l3[1], l3[2], l3[3], h3[0], h3[1], h3[2], h3[3]}, o[d0], 0, 0, 0); } while (0)
    PV_D0(0); PV_D0(1); PV_D0(2); PV_D0(3);
#undef PV_D0
#undef TRRD
}
__device__ __forceinline__ void attn_unit(int b, int h, int qb, const bf16_t* __restrict__ Q, const bf16_t* __restrict__ KVp, const bf16_t* __restrict__ KR, bf16_t* __restrict__ O, char* lds) {
    int tid_o = threadIdx.x; asm volatile("" : "+v"(tid_o)); const int tid = tid_o, wid = __builtin_amdgcn_readfirstlane(tid >> 6), lane = tid & 63, r32 = lane & 31, hi = lane >> 5;
    const size_t rowbase = (size_t)b * SEQ; const int q0 = qb * QB;
    char* V_lds = lds + OFF_V; char* K_lds = lds + OFF_K;
    float* ws = (float*)(lds + OFF_WS) + wid * 64; float* li_l = ws; float* al_l = ws + 32;
    bf16x8 qr[12];
    { const bf16_t* Qw = Q + (rowbase + q0 + wid * QBLK + r32) * NQ + h * DQK + hi * 8;
#pragma unroll
      for (int d0 = 0; d0 < 12; ++d0) qr[d0] = *reinterpret_cast<const bf16x8*>(Qw + d0 * 16); }
    const bf16_t* ksrc[3]; int kstr[3], kdst[3];
#pragma unroll
    for (int i = 0; i < 3; ++i) { const int c = tid + 512 * i, kr = c / 24, kc = c - kr * 24;
        if (kc < 16) { ksrc[i] = KVp + (rowbase + kr) * NKV + h * 256 + kc * 8; kstr[i] = KVBLK * NKV; }
        else { ksrc[i] = KR + (rowbase + kr) * 64 + (kc - 16) * 8; kstr[i] = KVBLK * 64; }
        kdst[i] = kr * KROW + kc * 16; }
    const int sr = tid >> 4, sc = (tid & 15) * 8;
    const bf16_t* vsrc = KVp + (rowbase + sr) * NKV + h * 256 + 128 + sc;
    const int vst0 = v_st(sr, sc), vst1 = v_st(32 + sr, sc);
    const int vb0 = (int)(uintptr_t)V_lds + v_rd_base(lane);
    const int NT = 4 * qb + 4;
    const int qlo = q0 + wid * QBLK, qm = qlo + r32 - 4 * hi;
    bf16x8 sk0, sk1, sk2, sv0, sv1;
#define SLOAD(t) do { sk0 = *reinterpret_cast<const bf16x8*>(ksrc[0] + (size_t)(t) * kstr[0]); sk1 = *reinterpret_cast<const bf16x8*>(ksrc[1] + (size_t)(t) * kstr[1]); \
        sk2 = *reinterpret_cast<const bf16x8*>(ksrc[2] + (size_t)(t) * kstr[2]); \
        sv0 = *reinterpret_cast<const bf16x8*>(vsrc + (size_t)(t) * KVBLK * NKV); sv1 = *reinterpret_cast<const bf16x8*>(vsrc + (size_t)(t) * KVBLK * NKV + 32 * NKV); } while (0)
#define SWRITE(bf) do { *reinterpret_cast<bf16x8*>(K_lds + (bf) * SHM_K + kdst[0]) = sk0; *reinterpret_cast<bf16x8*>(K_lds + (bf) * SHM_K + kdst[1]) = sk1; \
        *reinterpret_cast<bf16x8*>(K_lds + (bf) * SHM_K + kdst[2]) = sk2; \
        *reinterpret_cast<bf16x8*>(V_lds + (bf) * SHM_V + vst0) = sv0; *reinterpret_cast<bf16x8*>(V_lds + (bf) * SHM_V + vst1) = sv1; } while (0)
    SLOAD(0); SWRITE(0); __syncthreads();
    float m_reg = -1e30f, l_reg = 0.f; f32x16 o[4];
#pragma unroll
    for (int d = 0; d < 4; ++d) o[d] = f32x16{};
    for (int t = 0; t < NT; ++t) {
        const int cur = t & 1;
        if (t + 1 < NT) { SLOAD(t + 1); } SBAR();
        f32x16 p0, p1; float mn, alpha; bf16x8 pa0, pa1, pa2, pa3;
        qkt(p0, p1, K_lds + cur * SHM_K, r32, hi, qr);
        const int kb = t * KVBLK;
        if (kb + KVBLK - 1 > qlo) mask_tile(p0, p1, qm - kb);
        partialSM(p0, p1, m_reg, mn, alpha);
        if (__any(alpha < 1.f)) { if (hi == 0) al_l[r32] = alpha; asm volatile("s_waitcnt lgkmcnt(0)" ::: "memory");
#pragma unroll
            for (int d_ = 0; d_ < 4; ++d_)
#pragma unroll
                for (int r = 0; r < 16; ++r) o[d_][r] *= al_l[crow(r, hi)]; }
        finishSM(p0, p1, alpha, l_reg, pa0, pa1, pa2, pa3); SBAR();
        pv_tile(o, vb0 + cur * SHM_V, pa0, pa1, pa2, pa3);
        if (t + 1 < NT) { SWRITE(cur ^ 1); }
        __syncthreads();
    }
    if (hi == 0) li_l[r32] = l_reg; asm volatile("s_waitcnt lgkmcnt(0)" ::: "memory");
    float rli[16];
#pragma unroll
    for (int r = 0; r < 16; ++r) rli[r] = __builtin_amdgcn_rcpf(li_l[crow(r, hi)]);
    bf16_t* Ow = O + (rowbase + q0 + wid * QBLK) * DM + h * DV;
#pragma unroll
    for (int r = 0; r < 16; ++r) { const int orow = crow(r, hi);
#pragma unroll
        for (int d0 = 0; d0 < 4; ++d0) { const float v = o[d0][r] * rli[r]; const float vn = __shfl_xor(v, 1);
            if ((r32 & 1) == 0) *(unsigned*)(Ow + (size_t)orow * DM + d0 * 32 + r32) = cvtpk(v, vn); } }
    __syncthreads();
#undef SLOAD
#undef SWRITE
}
#undef SBAR
}
#define XB_TMO      128
#define XB_XCNT(j)  (256  + 64 * (j))
#define XB_XSUB(j)  (1280 + 64 * (j))
#define XB_XGEN(j)  (2304 + 64 * (j))
#define XB_TOP      3328
#define XB_TOPGEN   3392
#define XCD_BAR_WORDS 3456
#define XB_SPIN_CAP (1u << 18)

__device__ __forceinline__ unsigned xb_ld(unsigned* p)              { return __hip_atomic_load(p, __ATOMIC_RELAXED, __HIP_MEMORY_SCOPE_AGENT); }
__device__ __forceinline__ unsigned xb_add(unsigned* p, unsigned v) { return __hip_atomic_fetch_add(p, v, __ATOMIC_RELAXED, __HIP_MEMORY_SCOPE_AGENT); }
__device__ __forceinline__ unsigned xb_xcc_id() { return (unsigned)__builtin_amdgcn_s_getreg((3 << 11) | 20) & 0xFu; }
#define XB_SPIN(cond, bar) do { unsigned _sp = 0; while (cond) { __builtin_amdgcn_s_sleep(1); \
    if ((++_sp & 255u) == 0u) { if (xb_ld(&(bar)[XB_TMO])) break; if (_sp > XB_SPIN_CAP) { atomicAdd(&(bar)[XB_TMO], 1u); break; } } } } while (0)

struct XcdBarrier {
    unsigned* bar; unsigned x;
    volatile LAS unsigned* st;
};

__device__ __forceinline__ XcdBarrier xcd_barrier_post(unsigned* bar, volatile LAS unsigned* st) {
    XcdBarrier b; b.bar = bar; b.x = xb_xcc_id(); b.st = st;
    if (threadIdx.x == 0) (void)xb_add(&bar[XB_XCNT(b.x)], 1u);
    return b;
}
__device__ __forceinline__ void xcd_barrier_complete(unsigned* bar, unsigned x, unsigned& nloc, unsigned& nx) {
    const unsigned G = gridDim.x * gridDim.y * gridDim.z;
    unsigned sum, cnt, mine, sp = 0u;
    for (;;) {
        sum = 0u; cnt = 0u; mine = 0u;
#pragma unroll
        for (unsigned j = 0; j < 16; ++j) { const unsigned c = xb_ld(&bar[XB_XCNT(j)]); sum += c; cnt += (c > 0u) ? 1u : 0u; mine = (j == x) ? c : mine; }
        if (sum == G) break;
        __builtin_amdgcn_s_sleep(1);
        if ((++sp & 255u) == 0u) { if (xb_ld(&bar[XB_TMO])) break; if (sp > XB_SPIN_CAP) { atomicAdd(&bar[XB_TMO], 1u); break; } }
    }
    nloc = mine > 0u ? mine : 1u; nx = cnt > 0u ? cnt : 1u;
}

__device__ __forceinline__ void xcd_barrier(const XcdBarrier& b) {
    asm volatile("s_waitcnt vmcnt(0)" ::: "memory");
    __syncthreads();
    if (threadIdx.x == 0) {
        unsigned* bar = b.bar;
        __builtin_amdgcn_s_waitcnt(0);
        unsigned nloc = b.st[0], nx = b.st[1];
        if (nloc == 0u) { xcd_barrier_complete(bar, b.x, nloc, nx); b.st[0] = nloc; b.st[1] = nx; }
        const unsigned old = xb_add(&bar[XB_XSUB(b.x)], 1u);
        const unsigned gen = old / nloc;
        if (old + 1u == (gen + 1u) * nloc) {
            __builtin_amdgcn_fence(__ATOMIC_RELEASE, "agent");
            asm volatile("s_waitcnt vmcnt(0)" ::: "memory");
            const unsigned og = xb_add(&bar[XB_TOP], 1u);
            const unsigned tg = og / nx;
            if (og + 1u == (tg + 1u) * nx) xb_add(&bar[XB_TOPGEN], 1u);
            else XB_SPIN(xb_ld(&bar[XB_TOPGEN]) == tg, bar);
            __builtin_amdgcn_fence(__ATOMIC_ACQUIRE, "agent");
            xb_add(&bar[XB_XGEN(b.x)], 1u);
            asm volatile("s_waitcnt vmcnt(0)" ::: "memory");
        } else {
            XB_SPIN(xb_ld(&bar[XB_XGEN(b.x)]) == gen, bar);
            __builtin_amdgcn_fence(__ATOMIC_ACQUIRE, "agent");
            asm volatile("s_waitcnt vmcnt(0)" ::: "memory");
        }
    }
    __syncthreads();
}
using pg8::Gemm; using pg8::StaticOrder; using pg8::gemm_phase;
#define LDS_WAIT() asm volatile("s_waitcnt lgkmcnt(0)" ::: "memory")
constexpr int NWAVES = 8, NTHREADS = 512;
constexpr int LDS_BYTES = 135168;

__device__ __forceinline__ float wave_sum(float v) {
#pragma unroll
    for (int o = 1; o < 64; o <<= 1) v += __shfl_xor(v, o);
    return v;
}
__device__ __forceinline__ unsigned pk2(float lo, float hi) { return pg8::cvt_pk_bf16(lo, hi); }
__device__ __forceinline__ float bflo(unsigned u) { return __uint_as_float(u << 16); }
__device__ __forceinline__ float bfhi(unsigned u) { return __uint_as_float(u & 0xffff0000u); }
__device__ __forceinline__ void unpack8(const u32x4 w, float* f) { f[0] = bflo(w.x); f[1] = bfhi(w.x); f[2] = bflo(w.y); f[3] = bfhi(w.y); f[4] = bflo(w.z); f[5] = bfhi(w.z); f[6] = bflo(w.w); f[7] = bfhi(w.w); }
__device__ __forceinline__ u32x4 pack8f(const float* f) { u32x4 w; w.x = pk2(f[0], f[1]); w.y = pk2(f[2], f[3]); w.z = pk2(f[4], f[5]); w.w = pk2(f[6], f[7]); return w; }

template <int MAP> __device__ __forceinline__ int wmap(int n) {
    if (MAP == 1) { return n < 1280 ? n : (n < 1344 ? n + (PC_KR - 1280) : n - 64); }
    if (MAP == 2) { const int h = n / 192, w = n - h * 192; if (w < 128) return n; const int j = w - 128;
                    return h * 192 + 128 + (j < 32 ? 2 * j : 2 * (j - 32) + 1); }
    if (MAP == 3) { if (n < DFF) return (n >> 7) * 256 + (n & 127); const int n2 = n - DFF; return (n2 >> 7) * 256 + 128 + (n2 & 127); }
    return n;
}
template <int MAP> __device__ __forceinline__ void transpose_item(const float* __restrict__ W, int K, int N, bf16_t* __restrict__ WT, LAS float* scr, int item, int lane) {
    const int nblk = N / 32, kb = item / nblk, nb = item - kb * nblk, k0 = 64 * kb, n0 = 32 * nb;
    { const int lr = lane >> 3, lc = (lane & 7) * 4; f32x4 v[8];
#pragma unroll
      for (int i = 0; i < 8; ++i) v[i] = *(const f32x4*)(W + (size_t)(k0 + i * 8 + lr) * N + n0 + lc);
#pragma unroll
      for (int i = 0; i < 8; ++i) { LAS float* sp = scr + (i * 8 + lr) * 33 + lc; sp[0] = v[i][0]; sp[1] = v[i][1]; sp[2] = v[i][2]; sp[3] = v[i][3]; } }
    LDS_WAIT(); asm volatile("" ::: "memory");
    const int c = lane & 7;
#pragma unroll
    for (int j = 0; j < 4; ++j) { const int n = (lane >> 3) + 8 * j; const LAS float* s = scr + (8 * c) * 33 + n;
        u32x4 o; o.x = pk2(s[0 * 33], s[1 * 33]); o.y = pk2(s[2 * 33], s[3 * 33]); o.z = pk2(s[4 * 33], s[5 * 33]); o.w = pk2(s[6 * 33], s[7 * 33]);
        *(u32x4*)(WT + (size_t)wmap<MAP>(n0 + n) * K + k0 + 8 * c) = o; }
    LDS_WAIT(); asm volatile("" ::: "memory");
}

struct Args {
    const float* x; const float* c; const int* pos; const float* w_ada; const float* b_ada; const float* g_pre_mix; const float* g_post_mix;
    const float* w_in; const float* g_q; const float* w_uq; const float* g_kv; const float* w_ukv; const float* conv_w_mix; const float* conv_b_mix;
    const float* w_o; const float* g_pre_ffn; const float* g_post_ffn; const float* w_up; const float* conv_w_ffn; const float* conv_b_ffn; const float* w_down;
    float* out; unsigned char* ws;
};

__device__ __forceinline__ void ph_prologue(const Args& a, LAS unsigned char* lds, int G) {
    int tid_o = threadIdx.x; asm volatile("" : "+v"(tid_o)); const int tid = tid_o, lane = tid & 63, wave = tid >> 6;
    unsigned char* ws = a.ws;
    float* MOD = (float*)(ws + WS_MOD);
    for (int it = blockIdx.x; it < NMODC / 64; it += G) {
        LAS float* red = (LAS float*)lds;
        const int kg = tid >> 4, l16 = tid & 15, col = it * 64 + l16 * 4;
        f32x4 a0 = {0.f, 0.f, 0.f, 0.f}, a1 = {0.f, 0.f, 0.f, 0.f};
#pragma unroll 8
        for (int i = 0; i < 64; ++i) { const int k = kg + 32 * i;
            const f32x4 w = *(const f32x4*)(a.w_ada + (size_t)k * NMODC + col);
            const float c0 = a.c[k], c1 = a.c[DM + k];
            const float s0 = c0 / (1.f + __expf(-c0)), s1 = c1 / (1.f + __expf(-c1));
            a0 += w * s0; a1 += w * s1; }
        LAS float* rp = red + (kg * 16 + l16) * 8;
        rp[0] = a0[0]; rp[1] = a0[1]; rp[2] = a0[2]; rp[3] = a0[3]; rp[4] = a1[0]; rp[5] = a1[1]; rp[6] = a1[2]; rp[7] = a1[3];
        __syncthreads();
        if (tid < 128) { const int b = tid >> 6, cc = tid & 63; float s = 0.f;
            for (int g = 0; g < 32; ++g) s += red[(g * 16 + (cc >> 2)) * 8 + b * 4 + (cc & 3)];
            MOD[b * NMODC + it * 64 + cc] = s + a.b_ada[it * 64 + cc]; }
        __syncthreads();
    }
    LAS float* scr = (LAS float*)(lds + wave * 16384);
    const int gw = blockIdx.x * NWAVES + wave, NGW = G * NWAVES;
    bf16_t* WinT = (bf16_t*)(ws + WS_WIN); bf16_t* WuqT = (bf16_t*)(ws + WS_WUQ); bf16_t* WukvT = (bf16_t*)(ws + WS_WUKV);
    bf16_t* WoT = (bf16_t*)(ws + WS_WO); bf16_t* WupT = (bf16_t*)(ws + WS_WUP); bf16_t* WdnT = (bf16_t*)(ws + WS_WDN);
    constexpr int I_IN = (DM / 64) * (INC / 32), I_UQ = (QL / 64) * (NQ / 32), I_UKV = (KVL / 64) * (NKV / 32), I_O = (DM / 64) * (DM / 32), I_UP = (DM / 64) * (NUP / 32), I_DN = (DFF / 64) * (DM / 32);
    constexpr int I_UPD = I_UP / 3;
    constexpr int NITEMS = I_IN + I_UQ + I_UKV + I_O + (I_UP - I_UPD);
    for (int it = gw; it < NITEMS; it += NGW) {
        int r = it;
        if (r < I_UP - I_UPD) { transpose_item<3>(a.w_up, DM, NUP, WupT, scr, r + I_UPD, lane); continue; } r -= I_UP - I_UPD;
        if (r < I_IN) { transpose_item<1>(a.w_in, DM, INC, WinT, scr, r, lane); continue; } r -= I_IN;
        if (r < I_O) { transpose_item<0>(a.w_o, DM, DM, WoT, scr, r, lane); continue; } r -= I_O;
        if (r < I_UQ) { transpose_item<2>(a.w_uq, QL, NQ, WuqT, scr, r, lane); continue; } r -= I_UQ;
        transpose_item<0>(a.w_ukv, KVL, NKV, WukvT, scr, r, lane);
    }
    const int gt = blockIdx.x * NTHREADS + tid, NGT = G * NTHREADS;
    { u32x4* z = (u32x4*)(WinT + (size_t)INC * DM); const int nz = (INP - INC) * DM / 8;
      for (int i = gt; i < nz; i += NGT) z[i] = (u32x4){0u, 0u, 0u, 0u}; }
    { f32x2* CS = (f32x2*)(ws + WS_CS);
      for (int i = gt; i < M * 32; i += NGT) { const int row = i >> 5, j = i & 31;
          const float inv = 1.0f / exp2f((float)(2 * j) * (13.287712379549449f / 64.f));
          const float ang = (float)a.pos[row] * inv;
          const double rv = (double)ang * 0.15915494309189535; const float f = (float)(rv - __builtin_rint(rv));
          CS[i] = (f32x2){__builtin_amdgcn_cosf(f), __builtin_amdgcn_sinf(f)}; } }
}

__device__ __forceinline__ void ph_deferred(const Args& a, LAS unsigned char* lds, int rank, int n) {
    int tid_o = threadIdx.x; asm volatile("" : "+v"(tid_o)); const int tid = tid_o, lane = tid & 63, wave = tid >> 6;
    LAS float* scr = (LAS float*)(lds + wave * 16384);
    bf16_t* WupT = (bf16_t*)(a.ws + WS_WUP); bf16_t* WdnT = (bf16_t*)(a.ws + WS_WDN);
    constexpr int I_UP = (DM / 64) * (NUP / 32), I_DN = (DFF / 64) * (DM / 32), I_UPD = I_UP / 3;
    for (int it = rank * NWAVES + wave; it < I_DN + I_UPD; it += n * NWAVES) {
        if (it < I_DN) transpose_item<0>(a.w_down, DFF, DM, WdnT, scr, it, lane);
        else transpose_item<3>(a.w_up, DM, NUP, WupT, scr, it - I_DN, lane);
    }
}

__device__ __forceinline__ void ph_prenorm(const float* __restrict__ x, const float* __restrict__ g, const float* __restrict__ mod, int sh_i, int sc_i, bf16_t* __restrict__ XN, int gw, int NGW, int lane) {
    for (int row0 = gw; row0 < M; row0 += 2 * NGW) {
        int rows[2]; rows[0] = row0; rows[1] = row0 + NGW < M ? row0 + NGW : row0;
        f32x4 v[2][8];
#pragma unroll
        for (int q = 0; q < 2; ++q) { const f32x4* xr = (const f32x4*)(x + (size_t)rows[q] * DM) + lane;
#pragma unroll
            for (int j = 0; j < 8; ++j) v[q][j] = xr[64 * j]; }
#pragma unroll
        for (int q = 0; q < 2; ++q) { const int row = rows[q]; const float* mb = mod + (row >= SEQ ? NMODC : 0); float ss = 0.f;
#pragma unroll
            for (int j = 0; j < 8; ++j) ss += (v[q][j][0] * v[q][j][0] + v[q][j][1] * v[q][j][1]) + (v[q][j][2] * v[q][j][2] + v[q][j][3] * v[q][j][3]);
            const float rstd = rsqrtf(wave_sum(ss) * (1.f / DM) + RMS_EPS);
#pragma unroll
            for (int j = 0; j < 8; ++j) { const int e = (lane + 64 * j) * 4;
                const f32x4 g4 = *(const f32x4*)(g + e), s4 = *(const f32x4*)(mb + sc_i * DM + e), h4 = *(const f32x4*)(mb + sh_i * DM + e);
                const f32x4 o = v[q][j] * rstd * g4 * (s4 + 1.f) + h4;
                *(u32x2*)(XN + (size_t)row * DM + e) = (u32x2){pk2(o[0], o[1]), pk2(o[2], o[3])}; } }
    }
}

__device__ __forceinline__ void ph_mid(const Args& a, int gw, int NGW, int lane) {
    unsigned char* ws = a.ws;
    const bf16_t* PROJ = (const bf16_t*)(ws + WS_PROJ); const float* CS = (const float*)(ws + WS_CS);
    bf16_t* QN = (bf16_t*)(ws + WS_QN); bf16_t* KVN = (bf16_t*)(ws + WS_KVN); bf16_t* KR = (bf16_t*)(ws + WS_KR); bf16_t* MIXIN = (bf16_t*)(ws + WS_XN);
    for (int row = gw; row < M; row += NGW) {
        const bf16_t* pr = PROJ + (size_t)row * INP;
        {
            float f[3][4]; float ss = 0.f;
#pragma unroll
            for (int j = 0; j < 3; ++j) { const u32x2 w = *(const u32x2*)(pr + PC_Q + (lane + 64 * j) * 4);
                f[j][0] = bflo(w.x); f[j][1] = bfhi(w.x); f[j][2] = bflo(w.y); f[j][3] = bfhi(w.y);
                ss += (f[j][0] * f[j][0] + f[j][1] * f[j][1]) + (f[j][2] * f[j][2] + f[j][3] * f[j][3]); }
            const float rstd = rsqrtf(wave_sum(ss) * (1.f / QL) + RMS_EPS);
#pragma unroll
            for (int j = 0; j < 3; ++j) { const int e = (lane + 64 * j) * 4; const f32x4 g4 = *(const f32x4*)(a.g_q + e);
                *(u32x2*)(QN + (size_t)row * QL + e) = (u32x2){pk2(f[j][0] * rstd * g4[0], f[j][1] * rstd * g4[1]), pk2(f[j][2] * rstd * g4[2], f[j][3] * rstd * g4[3])}; }
        }
        {
            float f[8]; unpack8(*(const u32x4*)(pr + PC_KV + lane * 8), f); float ss = 0.f;
#pragma unroll
            for (int i = 0; i < 8; ++i) ss += f[i] * f[i];
            const float rstd = rsqrtf(wave_sum(ss) * (1.f / KVL) + RMS_EPS);
            const f32x4 g0 = *(const f32x4*)(a.g_kv + lane * 8), g1 = *(const f32x4*)(a.g_kv + lane * 8 + 4);
#pragma unroll
            for (int i = 0; i < 4; ++i) { f[i] *= rstd * g0[i]; f[4 + i] *= rstd * g1[i]; }
            *(u32x4*)(KVN + (size_t)row * KVL + lane * 8) = pack8f(f);
        }
        if (lane < 32) {
            const float x1 = __uint_as_float((unsigned)pr[PC_KR + lane] << 16), x2 = __uint_as_float((unsigned)pr[PC_KR + 32 + lane] << 16);
            const f32x2 cs = *(const f32x2*)(CS + (size_t)row * 64 + 2 * lane);
            *(unsigned*)(KR + (size_t)row * 64 + 2 * lane) = pk2(x1 * cs.x - x2 * cs.y, x2 * cs.x + x1 * cs.y);
        }
        const int tt = row & (SEQ - 1);
#pragma unroll
        for (int j = 0; j < 2; ++j) {
            const int c0 = lane * 8 + 512 * j;
            float gb[8], p0[8], p1[8], p2[8], t0[8], t1[8];
            unpack8(*(const u32x4*)(pr + PC_GB + c0), gb);
            unpack8(*(const u32x4*)(pr + PC_GC + c0), t0); unpack8(*(const u32x4*)(pr + PC_CI + c0), t1);
#pragma unroll
            for (int i = 0; i < 8; ++i) p0[i] = t0[i] * t1[i];
            const bf16_t* pr1 = pr - (tt >= 1 ? INP : 0); const bf16_t* pr2 = pr - (tt >= 2 ? 2 * INP : 0);
            const float m1 = tt >= 1 ? 1.f : 0.f, m2 = tt >= 2 ? 1.f : 0.f;
            unpack8(*(const u32x4*)(pr1 + PC_GC + c0), t0); unpack8(*(const u32x4*)(pr1 + PC_CI + c0), t1);
#pragma unroll
            for (int i = 0; i < 8; ++i) p1[i] = m1 * t0[i] * t1[i];
            unpack8(*(const u32x4*)(pr2 + PC_GC + c0), t0); unpack8(*(const u32x4*)(pr2 + PC_CI + c0), t1);
#pragma unroll
            for (int i = 0; i < 8; ++i) p2[i] = m2 * t0[i] * t1[i];
            float o[8];
#pragma unroll
            for (int i = 0; i < 8; ++i) { const float w0 = a.conv_w_mix[c0 + i], w1 = a.conv_w_mix[CW + c0 + i], w2 = a.conv_w_mix[2 * CW + c0 + i], bb = a.conv_b_mix[c0 + i];
                o[i] = gb[i] * (w0 * p2[i] + w1 * p1[i] + w2 * p0[i] + bb); }
            *(u32x4*)(MIXIN + (size_t)row * DM + CW + c0) = pack8f(o);
        }
    }
}

__device__ __forceinline__ void ph_post_mix(const Args& a, int gw, int NGW, int lane) {
    unsigned char* ws = a.ws; const bf16_t* MIX = (const bf16_t*)(ws + WS_PROJ); const float* mod = (const float*)(ws + WS_MOD); bf16_t* XN2 = (bf16_t*)(ws + WS_XN);
    for (int row0 = gw; row0 < M; row0 += 2 * NGW) {
      int rows[2]; rows[0] = row0; rows[1] = row0 + NGW < M ? row0 + NGW : row0;
      u32x4 wq[2][4]; f32x4 xq[2][8];
#pragma unroll
      for (int q = 0; q < 2; ++q) { const f32x4* xr = (const f32x4*)(a.x + (size_t)rows[q] * DM) + 2 * lane;
#pragma unroll
          for (int j = 0; j < 4; ++j) { wq[q][j] = *(const u32x4*)(MIX + (size_t)rows[q] * DM + (lane + 64 * j) * 8); xq[q][2 * j] = xr[128 * j]; xq[q][2 * j + 1] = xr[128 * j + 1]; } }
#pragma unroll
      for (int q = 0; q < 2; ++q) {
        const int row = rows[q];
        const float* mb = mod + (row >= SEQ ? NMODC : 0);
        f32x4 v[8], xv[8]; float ss = 0.f;
#pragma unroll
        for (int j = 0; j < 4; ++j) { const u32x4 w = wq[q][j]; xv[2 * j] = xq[q][2 * j]; xv[2 * j + 1] = xq[q][2 * j + 1];
            v[2 * j] = (f32x4){bflo(w.x), bfhi(w.x), bflo(w.y), bfhi(w.y)}; v[2 * j + 1] = (f32x4){bflo(w.z), bfhi(w.z), bflo(w.w), bfhi(w.w)}; }
#pragma unroll
        for (int j = 0; j < 8; ++j) ss += (v[j][0] * v[j][0] + v[j][1] * v[j][1]) + (v[j][2] * v[j][2] + v[j][3] * v[j][3]);
        const float rstd = rsqrtf(wave_sum(ss) * (1.f / DM) + RMS_EPS);
        float ss2 = 0.f;
#pragma unroll
        for (int j = 0; j < 8; ++j) { const int e = (lane + 64 * (j >> 1)) * 8 + (j & 1) * 4;
            const f32x4 g4 = *(const f32x4*)(a.g_post_mix + e), gt = *(const f32x4*)(mb + 2 * DM + e);
            const f32x4 x1 = xv[j] + gt * (v[j] * rstd * g4);
            *(f32x4*)(a.out + (size_t)row * DM + e) = x1; v[j] = x1;
            ss2 += (x1[0] * x1[0] + x1[1] * x1[1]) + (x1[2] * x1[2] + x1[3] * x1[3]); }
        const float rstd2 = rsqrtf(wave_sum(ss2) * (1.f / DM) + RMS_EPS);
#pragma unroll
        for (int j = 0; j < 4; ++j) { const int e = (lane + 64 * j) * 8; f32x4 o[2];
#pragma unroll
            for (int hh = 0; hh < 2; ++hh) { const f32x4 g4 = *(const f32x4*)(a.g_pre_ffn + e + 4 * hh), s4 = *(const f32x4*)(mb + 4 * DM + e + 4 * hh), h4 = *(const f32x4*)(mb + 3 * DM + e + 4 * hh);
                o[hh] = v[2 * j + hh] * rstd2 * g4 * (s4 + 1.f) + h4; }
            *(u32x4*)(XN2 + (size_t)row * DM + e) = (u32x4){pk2(o[0][0], o[0][1]), pk2(o[0][2], o[0][3]), pk2(o[1][0], o[1][1]), pk2(o[1][2], o[1][3])}; }
      }
    }
}

__device__ __forceinline__ void ph_fixup(const Args& a, int gt, int NGT) {
    unsigned char* ws = a.ws; const float* HL = (const float*)(ws + WS_HL); const float* HF = (const float*)(ws + WS_HF); bf16_t* ACT = (bf16_t*)(ws + WS_ACT);
    constexpr int NTN = NUP / 256;
    for (int idx = gt; idx < (M / 256) * NTN * 128; idx += NGT) {
        const int unit = idx >> 7, ch = idx & 127, pm = unit / NTN, pn = unit - pm * NTN, cg = pn * 128 + ch;
        const float* F = HF + (size_t)unit * 512 + ch; const bool first = (pm & (SEQ / 256 - 1)) == 0; const float* L = HL + (size_t)(first ? unit : unit - NTN) * 512 + ch;
        const float lm = first ? 0.f : 1.f;
        const float a6 = lm * L[0], g6 = lm * L[128], a7 = lm * L[256], g7 = lm * L[384], a0 = F[0], g0 = F[128], a1 = F[256], g1 = F[384];
        const float wa0 = a.conv_w_ffn[cg], wa1 = a.conv_w_ffn[NUP + cg], wa2 = a.conv_w_ffn[2 * NUP + cg], ba = a.conv_b_ffn[cg];
        const float wg0 = a.conv_w_ffn[DFF + cg], wg1 = a.conv_w_ffn[NUP + DFF + cg], wg2 = a.conv_w_ffn[2 * NUP + DFF + cg], bg = a.conv_b_ffn[DFF + cg];
        const float ua0 = wa0 * a6 + wa1 * a7 + wa2 * a0 + ba, ug0 = wg0 * g6 + wg1 * g7 + wg2 * g0 + bg;
        const float ua1 = wa0 * a7 + wa1 * a0 + wa2 * a1 + ba, ug1 = wg0 * g7 + wg1 * g0 + wg2 * g1 + bg;
        const float o0 = ua0 * ug0 * __builtin_amdgcn_rcpf(1.f + __expf(-ug0)), o1 = ua1 * ug1 * __builtin_amdgcn_rcpf(1.f + __expf(-ug1));
        bf16_t* op = ACT + (size_t)(pm * 256) * DFF + cg;
        op[0] = (bf16_t)(pk2(o0, o0) & 0xffffu); op[DFF] = (bf16_t)(pk2(o1, o1) & 0xffffu);
    }
}

__device__ __forceinline__ void ph_final(const Args& a, int gw, int NGW, int lane) {
    unsigned char* ws = a.ws; const bf16_t* Y = (const bf16_t*)(ws + WS_Y); const float* mod = (const float*)(ws + WS_MOD);
    for (int row0 = gw; row0 < M; row0 += 2 * NGW) {
      int rows[2]; rows[0] = row0; rows[1] = row0 + NGW < M ? row0 + NGW : row0;
      u32x4 wq[2][4]; f32x4 xq[2][8];
#pragma unroll
      for (int q = 0; q < 2; ++q) { const f32x4* xr = (const f32x4*)(a.out + (size_t)rows[q] * DM) + 2 * lane;
#pragma unroll
          for (int j = 0; j < 4; ++j) { wq[q][j] = *(const u32x4*)(Y + (size_t)rows[q] * DM + (lane + 64 * j) * 8); xq[q][2 * j] = xr[128 * j]; xq[q][2 * j + 1] = xr[128 * j + 1]; } }
#pragma unroll
      for (int q = 0; q < 2; ++q) {
        const int row = rows[q];
        if (q == 1 && rows[1] == rows[0]) break;
        const float* mb = mod + (row >= SEQ ? NMODC : 0);
        f32x4 v[8], xv[8]; float ss = 0.f;
#pragma unroll
        for (int j = 0; j < 4; ++j) { const u32x4 w = wq[q][j]; xv[2 * j] = xq[q][2 * j]; xv[2 * j + 1] = xq[q][2 * j + 1];
            v[2 * j] = (f32x4){bflo(w.x), bfhi(w.x), bflo(w.y), bfhi(w.y)}; v[2 * j + 1] = (f32x4){bflo(w.z), bfhi(w.z), bflo(w.w), bfhi(w.w)}; }
#pragma unroll
        for (int j = 0; j < 8; ++j) ss += (v[j][0] * v[j][0] + v[j][1] * v[j][1]) + (v[j][2] * v[j][2] + v[j][3] * v[j][3]);
        const float rstd = rsqrtf(wave_sum(ss) * (1.f / DM) + RMS_EPS);
#pragma unroll
        for (int j = 0; j < 8; ++j) { const int e = (lane + 64 * (j >> 1)) * 8 + (j & 1) * 4;
            const f32x4 g4 = *(const f32x4*)(a.g_post_ffn + e), gt = *(const f32x4*)(mb + 5 * DM + e);
            *(f32x4*)(a.out + (size_t)row * DM + e) = xv[j] + gt * (v[j] * rstd * g4); }
      }
    }
}

#ifndef PROBE_THIN
#define PROBE_THIN 1
#endif
#ifndef PROBE_ATT
#define PROBE_ATT 1
#endif
constexpr int LDS_MISC = 131072 + 256, LDS_X = 131072 + 1024;
constexpr int LDS_MISC_ = 0;
constexpr size_t WS_BAR = 67 * MiB, BAR_BYTES = 16384;
#ifndef STAGGER_TICKS
#define STAGGER_TICKS 0
#endif
__device__ __forceinline__ void stagger(int bid) {
    if (STAGGER_TICKS > 0) {
        if (threadIdx.x == 0) { const unsigned long long t0 = __builtin_amdgcn_s_memrealtime(); const unsigned long long d = (unsigned long long)(((bid >> 3) & 7) * STAGGER_TICKS);
            while (__builtin_amdgcn_s_memrealtime() - t0 < d) __builtin_amdgcn_s_sleep(8); }
        __syncthreads();
    }
}
__global__ void __launch_bounds__(NTHREADS, 2) mega_fwd(Args a) {
    extern __shared__ __attribute__((aligned(16))) unsigned char lds_raw[];
    cg::grid_group grid = cg::this_grid();
    LAS unsigned char* lds = (LAS unsigned char*)lds_raw;
    const int tid = threadIdx.x, lane = tid & 63, wave = __builtin_amdgcn_readfirstlane(tid >> 6);
    const int G = gridDim.x, bid = blockIdx.x;
    const int gw = bid * NWAVES + wave, NGW = G * NWAVES, gt = bid * NTHREADS + tid, NGT = G * NTHREADS;
    unsigned char* ws = a.ws;
    bf16_t* XN = (bf16_t*)(ws + WS_XN);
    volatile LAS unsigned* misc = (volatile LAS unsigned*)(lds + LDS_MISC);
    if (tid < 2) misc[tid] = 0u;
    __syncthreads();
    const XcdBarrier xbar = xcd_barrier_post((unsigned*)(ws + WS_BAR), misc);
    if (a.out == nullptr) grid.sync();
#define GRID_BAR() xcd_barrier(xbar)

    ph_prologue(a, lds, G);
    GRID_BAR();
    for (int rep = 0; rep < PROBE_THIN; ++rep) ph_prenorm(a.x, a.g_pre_mix, (const float*)(ws + WS_MOD), 0, 1, XN, gw, NGW, lane);
    GRID_BAR();
    {
        Gemm g{XN, (const bf16_t*)(ws + WS_WIN), M, INP, DM}; StaticOrder S; S.init(M, INP, G, bid);
        pg8::EpiBf16 E{(bf16_t*)(ws + WS_PROJ), INP};
        stagger(bid); gemm_phase<pg8::EpiBf16, StaticOrder, true, true>(lds, g, S, E);
        const int nwg = (M / 256) * (INP / 256), full = nwg / G, rem = nwg - full * G;
        if (rem == 0) ph_deferred(a, lds, bid, G); else if (bid >= rem) ph_deferred(a, lds, bid - rem, G - rem);
    }
    GRID_BAR();
    for (int rep = 0; rep < PROBE_THIN; ++rep) ph_mid(a, gw, NGW, lane);
    GRID_BAR();
    {
        Gemm g{(const bf16_t*)(ws + WS_QN), (const bf16_t*)(ws + WS_WUQ), M, NQ, QL}; StaticOrder S; S.init(M, NQ, G, bid);
        pg8::EpiQ E{(bf16_t*)(ws + WS_Q), (const float*)(ws + WS_CS)};
        stagger(bid); gemm_phase<pg8::EpiQ, StaticOrder, true, true>(lds, g, S, E);
        Gemm g2{(const bf16_t*)(ws + WS_KVN), (const bf16_t*)(ws + WS_WUKV), M, NKV, KVL}; StaticOrder S2; S2.init(M, NKV, G, bid);
        pg8::EpiBf16 E2{(bf16_t*)(ws + WS_KV), NKV};
        gemm_phase<pg8::EpiBf16, StaticOrder, true, true>(lds, g2, S2, E2);
    }
    GRID_BAR();
    {
        for (int rep = 0; rep < PROBE_ATT; ++rep)
        for (int L = bid; L < 256; L += G) {
            const int v = (L & 7) * 32 + (L >> 3), bh = v >> 4, s = v & 15;
            att::attn_unit(bh >> 3, bh & 7, 31 - s, (const bf16_t*)(ws + WS_Q), (const bf16_t*)(ws + WS_KV), (const bf16_t*)(ws + WS_KR), XN, (char*)lds_raw);
            att::attn_unit(bh >> 3, bh & 7, s, (const bf16_t*)(ws + WS_Q), (const bf16_t*)(ws + WS_KV), (const bf16_t*)(ws + WS_KR), XN, (char*)lds_raw);
        }
    }
    GRID_BAR();
    {
        Gemm g{XN, (const bf16_t*)(ws + WS_WO), M, DM, DM}; StaticOrder S; S.init(M, DM, G, bid);
        pg8::EpiBf16 E{(bf16_t*)(ws + WS_PROJ), DM};
        stagger(bid); gemm_phase<pg8::EpiBf16, StaticOrder, true, true>(lds, g, S, E);
    }
    GRID_BAR();
    for (int rep = 0; rep < PROBE_THIN; ++rep) ph_post_mix(a, gw, NGW, lane);
    GRID_BAR();
    {
        Gemm g{XN, (const bf16_t*)(ws + WS_WUP), M, NUP, DM}; StaticOrder S; S.init(M, NUP, G, bid);
        pg8::EpiAct E{(bf16_t*)(ws + WS_ACT), a.conv_w_ffn, a.conv_b_ffn, (float*)(ws + WS_HL), (float*)(ws + WS_HF), (LAS float*)(lds + LDS_X), NUP / 256, DFF};
        gemm_phase<pg8::EpiAct, StaticOrder, true, true>(lds, g, S, E);
    }
    GRID_BAR();
    ph_fixup(a, gt, NGT);
    GRID_BAR();
    {
        Gemm g{(const bf16_t*)(ws + WS_ACT), (const bf16_t*)(ws + WS_WDN), M, DM, DFF}; StaticOrder S; S.init(M, DM, G, bid);
        pg8::EpiBf16 E{(bf16_t*)(ws + WS_Y), DM};
        stagger(bid); gemm_phase<pg8::EpiBf16, StaticOrder, true, true>(lds, g, S, E);
    }
    GRID_BAR();
    ph_final(a, gw, NGW, lane);
}

extern "C" void kernel_launch(void* const* d_in, const int* in_sizes, int n_in, void* d_out, int out_size, void* d_ws, size_t ws_size, hipStream_t stream) {
    static int grid = 0;
    if (grid == 0) {
        if (n_in != 21 || in_sizes[0] != M * DM || out_size != M * DM || ws_size < WS_END) {
            fprintf(stderr, "kernel_launch: unexpected shapes (n_in %d, in0 %d, out %d, ws %zu; need ws >= %zu)\n", n_in, n_in > 0 ? in_sizes[0] : -1, out_size, ws_size, (size_t)WS_END); grid = -1; return; }
        int dev = 0, cus = 0, per_cu = 0;
        (void)hipGetDevice(&dev);
        (void)hipDeviceGetAttribute(&cus, hipDeviceAttributeMultiprocessorCount, dev);
        if (hipFuncSetAttribute((const void*)mega_fwd, hipFuncAttributeMaxDynamicSharedMemorySize, LDS_BYTES) != hipSuccess) { fprintf(stderr, "kernel_launch: hipFuncSetAttribute failed\n"); grid = -1; return; }
        if (hipOccupancyMaxActiveBlocksPerMultiprocessor(&per_cu, (const void*)mega_fwd, NTHREADS, LDS_BYTES) != hipSuccess || per_cu < 1) { fprintf(stderr, "kernel_launch: occupancy query failed (%d)\n", per_cu); (void)hipGetLastError(); per_cu = 1; }
        grid = cus * per_cu;
        fprintf(stderr, "kernel_launch: %d CUs x %d workgroups\n", cus, per_cu);
    }
    if (grid < 0) return;
    if (hipMemsetAsync((char*)d_ws + WS_BAR, 0, BAR_BYTES, stream) != hipSuccess) { fprintf(stderr, "kernel_launch: memset failed\n"); return; }
    Args a{};
    a.x = (const float*)d_in[0]; a.c = (const float*)d_in[1]; a.pos = (const int*)d_in[2]; a.w_ada = (const float*)d_in[3]; a.b_ada = (const float*)d_in[4];
    a.g_pre_mix = (const float*)d_in[5]; a.g_post_mix = (const float*)d_in[6]; a.w_in = (const float*)d_in[7]; a.g_q = (const float*)d_in[8]; a.w_uq = (const float*)d_in[9];
    a.g_kv = (const float*)d_in[10]; a.w_ukv = (const float*)d_in[11]; a.conv_w_mix = (const float*)d_in[12]; a.conv_b_mix = (const float*)d_in[13]; a.w_o = (const float*)d_in[14];
    a.g_pre_ffn = (const float*)d_in[15]; a.g_post_ffn = (const float*)d_in[16]; a.w_up = (const float*)d_in[17]; a.conv_w_ffn = (const float*)d_in[18]; a.conv_b_ffn = (const float*)d_in[19];
    a.w_down = (const float*)d_in[20]; a.out = (float*)d_out; a.ws = (unsigned char*)d_ws;
    void* args[] = {&a};
    hipError_t e = hipLaunchCooperativeKernel((const void*)mega_fwd, dim3(grid), dim3(NTHREADS), args, LDS_BYTES, stream);
    if (e != hipSuccess) fprintf(stderr, "kernel_launch: cooperative launch failed: %s (grid %d)\n", hipGetErrorString(e), grid);
}
```
